# Optimizing an MI355X kernel written in HIP

```python
import jax, jax.numpy as jnp
from jax import lax
import numpy as np

D_MODEL = 2048
BATCH = 4
SEQ = 4096
DEPTH = 1

CHUNK = 64
LEFT_CHUNKS = 8
BAND = LEFT_CHUNKS + 1
ATT_HEADS = 8
ATT_HEAD_DIM = 128
ATT_WIDTH = ATT_HEADS * ATT_HEAD_DIM
REL_CLIP = 128
CONV_WIDTH = 1024
CONV_K = 3
MEM_LEN = 256
MEM_HEADS = 4
MEM_HEAD_DIM = D_MODEL // MEM_HEADS
PEER_HEADS = 8
PEER_NKEYS = 128
PEER_EXPERTS = PEER_NKEYS * PEER_NKEYS
PEER_QDIM = 256
PEER_HALF = PEER_QDIM // 2
PEER_TOPK = 16
PEER_TOKEN_BLOCK = 128
N_BRANCHES = 2
EPS = 1e-6
NEG_INF = -1e30
IN_SIZES = (ATT_WIDTH, ATT_WIDTH, ATT_WIDTH, CONV_WIDTH, CONV_WIDTH, CONV_WIDTH, D_MODEL, D_MODEL)
IN_COLS = sum(IN_SIZES)

kernel_name = 'hybrid_chunked_attn_shortconv_peer_block'


def rmsnorm(x, g):
    xf = x.astype(jnp.float32)
    y = xf * lax.rsqrt(jnp.mean(xf * xf, axis=-1, keepdims=True) + EPS)
    return (y * g.astype(jnp.float32)).astype(x.dtype)


def band_rel_bias(rel_table):
    a = jnp.arange(CHUNK)[:, None, None]
    j = jnp.arange(BAND)[None, :, None]
    b = jnp.arange(CHUNK)[None, None, :]
    rel = (LEFT_CHUNKS - j) * CHUNK + a - b
    idx = jnp.clip(rel, -REL_CLIP, REL_CLIP) + REL_CLIP
    return rel_table[:, idx]


def chunked_band_attention(q, k, v, rel_table):
    bsz, seq = q.shape[0], q.shape[1]
    nc = seq // CHUNK
    shp = (bsz, nc, CHUNK, ATT_HEADS, ATT_HEAD_DIM)
    qc = q.reshape(shp)
    pad = ((0, 0), (LEFT_CHUNKS, 0), (0, 0), (0, 0), (0, 0))
    kp = jnp.pad(k.reshape(shp), pad)
    vp = jnp.pad(v.reshape(shp), pad)
    s = jnp.stack([jnp.einsum('bnqhd,bnkhd->bnhqk', qc, kp[:, j:j + nc]) for j in range(BAND)], axis=4)
    s = s.astype(jnp.float32) * (ATT_HEAD_DIM ** -0.5)
    s = s + band_rel_bias(rel_table).astype(jnp.float32)
    src = jnp.arange(nc)[:, None] + jnp.arange(BAND)[None, :] - LEFT_CHUNKS
    valid = (src >= 0)[None, :, None, None, :, None]
    s = jnp.where(valid, s, NEG_INF)
    p = jax.nn.softmax(s.reshape(bsz, nc, ATT_HEADS, CHUNK, BAND * CHUNK), axis=-1)
    p = p.reshape(bsz, nc, ATT_HEADS, CHUNK, BAND, CHUNK).astype(v.dtype)
    o = jnp.einsum('bnhqk,bnkhd->bnqhd', p[:, :, :, :, 0], vp[:, 0:nc])
    for j in range(1, BAND):
        o = o + jnp.einsum('bnhqk,bnkhd->bnqhd', p[:, :, :, :, j], vp[:, j:j + nc])
    return o.reshape(bsz, seq, ATT_WIDTH)


def causal_depthwise_conv(u, w, b):
    seq = u.shape[1]
    up = jnp.pad(u, ((0, 0), (CONV_K - 1, 0), (0, 0)))
    y = up[:, 0:seq] * w[0] + b
    for i in range(1, CONV_K):
        y = y + up[:, i:i + seq] * w[i]
    return y


def memory_cross_attention(h, mem_n, w_cq, w_ck, w_cv, w_co):
    bsz, seq = h.shape[0], h.shape[1]
    mlen = mem_n.shape[1]
    q = (h @ w_cq).reshape(bsz, seq, MEM_HEADS, MEM_HEAD_DIM)
    k = (mem_n @ w_ck).reshape(bsz, mlen, MEM_HEADS, MEM_HEAD_DIM)
    v = (mem_n @ w_cv).reshape(bsz, mlen, MEM_HEADS, MEM_HEAD_DIM)
    s = jnp.einsum('bshd,bmhd->bhsm', q, k).astype(jnp.float32) * (MEM_HEAD_DIM ** -0.5)
    p = jax.nn.softmax(s, axis=-1).astype(v.dtype)
    o = jnp.einsum('bhsm,bmhd->bshd', p, v).reshape(bsz, seq, D_MODEL)
    return o @ w_co


def peer_ffn(h, w_pq, sub_keys, expert_u, expert_v):
    bsz, seq, dm = h.shape
    q = (h @ w_pq).reshape(bsz, seq, PEER_HEADS, 2, PEER_HALF)
    s = jnp.einsum('bshpd,hpkd->bshpk', q, sub_keys).astype(jnp.float32)
    s1, i1 = lax.top_k(s[:, :, :, 0], PEER_TOPK)
    s2, i2 = lax.top_k(s[:, :, :, 1], PEER_TOPK)
    cand = (s1[..., :, None] + s2[..., None, :]).reshape(bsz, seq, PEER_HEADS, PEER_TOPK * PEER_TOPK)
    cand_idx = (i1[..., :, None] * PEER_NKEYS + i2[..., None, :]).reshape(bsz, seq, PEER_HEADS, PEER_TOPK * PEER_TOPK)
    top_s, pos = lax.top_k(cand, PEER_TOPK)
    idx = jnp.take_along_axis(cand_idx, pos, axis=-1)
    gates = jax.nn.softmax(top_s, axis=-1).astype(h.dtype)
    n_tok = bsz * seq
    n_sel = PEER_HEADS * PEER_TOPK
    nb = n_tok // PEER_TOKEN_BLOCK
    hb = h.reshape(nb, PEER_TOKEN_BLOCK, dm)
    ib = idx.reshape(nb, PEER_TOKEN_BLOCK, n_sel)
    gb = gates.reshape(nb, PEER_TOKEN_BLOCK, n_sel)

    def block(args):
        hx, ix, gx = args
        u_sel = expert_u[ix]
        act = jax.nn.gelu(jnp.einsum('td,ted->te', hx, u_sel), approximate=False) * gx
        v_sel = expert_v[ix]
        return jnp.einsum('te,ted->td', act, v_sel)

    out = lax.map(block, (hb, ib, gb))
    return out.reshape(bsz, seq, dm)


def setup_inputs(seed: int = 0) -> dict:
    key = jax.random.key(seed)
    ks = jax.random.split(key, 24)

    def nrm(k, shape, scale):
        return jax.random.normal(k, shape, jnp.float32) * scale

    def gain(k, shape):
        return 1.0 + 0.05 * jax.random.normal(k, shape, jnp.float32)

    L, D = DEPTH, D_MODEL
    return {
        'x': nrm(ks[0], (BATCH, SEQ, D), 1.0),
        'mem': nrm(ks[1], (BATCH, MEM_LEN, D), 1.0),
        'norm_mix': gain(ks[2], (L, D)),
        'w_in': nrm(ks[3], (L, D, IN_COLS), D ** -0.5),
        'conv_w': nrm(ks[4], (L, CONV_K, CONV_WIDTH), CONV_K ** -0.5),
        'conv_b': nrm(ks[5], (L, CONV_WIDTH), 0.02),
        'rel_bias': nrm(ks[6], (L, ATT_HEADS, 2 * REL_CLIP + 1), 0.5),
        'w_att_out': nrm(ks[7], (L, ATT_WIDTH, D), ATT_WIDTH ** -0.5),
        'w_conv_out': nrm(ks[8], (L, CONV_WIDTH, D), CONV_WIDTH ** -0.5),
        'w_mix_out': nrm(ks[9], (L, D, D), D ** -0.5),
        'norm_cross': gain(ks[10], (L, D)),
        'norm_mem': gain(ks[11], (L, D)),
        'w_cq': nrm(ks[12], (L, D, D), D ** -0.5),
        'w_ck': nrm(ks[13], (L, D, D), D ** -0.5),
        'w_cv': nrm(ks[14], (L, D, D), D ** -0.5),
        'w_co': nrm(ks[15], (L, D, D), D ** -0.5),
        'norm_peer': gain(ks[16], (L, D)),
        'w_pq': nrm(ks[17], (L, D, PEER_HEADS * PEER_QDIM), D ** -0.5),
        'sub_keys': nrm(ks[18], (L, PEER_HEADS, 2, PEER_NKEYS, PEER_HALF), PEER_HALF ** -0.5),
        'expert_u': nrm(ks[19], (L, PEER_EXPERTS, D), D ** -0.5),
        'expert_v': nrm(ks[20], (L, PEER_EXPERTS, D), PEER_HEADS ** -0.5),
        'norm_final': gain(ks[21], (D,)),
    }


def reference(x, mem, norm_mix, w_in, conv_w, conv_b, rel_bias, w_att_out, w_conv_out, w_mix_out,
              norm_cross, norm_mem, w_cq, w_ck, w_cv, w_co, norm_peer, w_pq, sub_keys,
              expert_u, expert_v, norm_final):
    bsz, seq = x.shape[0], x.shape[1]
    split_at = [int(c) for c in np.cumsum(IN_SIZES)[:-1]]
    for l in range(DEPTH):
        h = rmsnorm(x, norm_mix[l])
        proj = h @ w_in[l]
        q, k, v, u, bgate, cgate, ga, gb = jnp.split(proj, split_at, axis=-1)
        hs = (bsz, seq, ATT_HEADS, ATT_HEAD_DIM)
        y_att = chunked_band_attention(q.reshape(hs), k.reshape(hs), v.reshape(hs), rel_bias[l]) @ w_att_out[l]
        y_conv = (bgate * causal_depthwise_conv(cgate * u, conv_w[l], conv_b[l])) @ w_conv_out[l]
        merged = jax.nn.sigmoid(ga) * y_att + jax.nn.sigmoid(gb) * y_conv
        x = x + merged @ w_mix_out[l]
        h = rmsnorm(x, norm_cross[l])
        mem_n = rmsnorm(mem, norm_mem[l])
        x = x + memory_cross_attention(h, mem_n, w_cq[l], w_ck[l], w_cv[l], w_co[l])
        h = rmsnorm(x, norm_peer[l])
        x = x + peer_ffn(h, w_pq[l], sub_keys[l], expert_u[l], expert_v[l])
    return rmsnorm(x, norm_final)
```

```cpp
#include <hip/hip_runtime.h>
#include <cstdio>
#include <cstdint>

#define DI __device__ __forceinline__
#define LAS __attribute__((address_space(3)))
#define GAS __attribute__((address_space(1)))
typedef unsigned short bf16_t;
typedef short bf16x8 __attribute__((ext_vector_type(8)));
typedef float f32x4 __attribute__((ext_vector_type(4)));
typedef unsigned u32x4 __attribute__((ext_vector_type(4)));
typedef float f32x2v __attribute__((ext_vector_type(2)));

constexpr int D = 2048, NB = 4, SEQ = 4096, M = NB * SEQ;
constexpr int INC = 10240, PA = 6144, PG = 4096;
constexpr int MROWS = 1024;
constexpr int NEXP = 16384;
constexpr float EPS = 1e-6f;
constexpr int NWAVES = 8, NTHR = 512;

constexpr size_t MiB = 1u << 20;
constexpr size_t WS_CTL = 0;
constexpr size_t WS_WINT = 1 * MiB;
constexpr size_t WS_WKVT = 41 * MiB;
constexpr size_t WS_WATT = 57 * MiB;
constexpr size_t WS_WCONV = 61 * MiB;
constexpr size_t WS_WMIX = 65 * MiB;
constexpr size_t WS_WCOT = 73 * MiB;
constexpr size_t WS_WCQN = 81 * MiB;
constexpr size_t WS_WPPT = 89 * MiB;
constexpr size_t WS_WST = 97 * MiB;
constexpr size_t WS_WOT = 113 * MiB;
constexpr size_t WS_MEMN = 129 * MiB;
constexpr size_t WS_KVM = 133 * MiB;
constexpr size_t WS_H1 = 141 * MiB;
constexpr size_t WS_OATT = 141 * MiB;
constexpr size_t WS_YC = 173 * MiB;
constexpr size_t WS_X1BF = 141 * MiB;
constexpr size_t WS_X2BF = 141 * MiB;
constexpr size_t WS_EU = 535 * MiB;
constexpr size_t WS_EV = 559 * MiB;
constexpr size_t WS_SCU = 583 * MiB;
constexpr size_t WS_SCV = 583 * MiB + 65536;
constexpr size_t WS_SSQ = 21 * MiB + 131072;
constexpr size_t WS_ACT = 22 * MiB;
constexpr size_t WS_YB = 269 * MiB;
constexpr size_t WS_PD = 205 * MiB;
constexpr size_t WS_PROJA = 205 * MiB;
constexpr size_t WS_MERGED = 205 * MiB;
constexpr size_t WS_PB = 205 * MiB;
constexpr size_t WS_SCR = 269 * MiB;
constexpr size_t WS_X2F = 269 * MiB;
constexpr size_t WS_PROJG = 397 * MiB;
constexpr size_t WS_X1F = 397 * MiB;
constexpr size_t WS_SCORES = 397 * MiB;
constexpr size_t WS_AKEYS = 525 * MiB;
constexpr size_t WS_WPQN = 526 * MiB;
constexpr size_t WS_END = 584 * MiB;
constexpr size_t WS_PART1 = 1 * MiB;
constexpr size_t WS_PART2 = 3 * MiB;
constexpr size_t WS_IDX = 5 * MiB;
constexpr size_t WS_GATE = 13 * MiB;

constexpr int RING_BYTES = 131072;
constexpr int SPARE_OFF = RING_BYTES;
constexpr int MISC_OFF = RING_BYTES + 12288;
constexpr int LDS_BYTES = 147456;

DI float bf2f(unsigned v) { return __uint_as_float(v << 16); }
DI unsigned f2bf(float f) { unsigned u = __float_as_uint(f); return (u + 0x7fffu + ((u >> 16) & 1u)) >> 16; }
DI unsigned pk2(float lo, float hi) { unsigned r; asm("v_cvt_pk_bf16_f32 %0, %1, %2" : "=v"(r) : "v"(lo), "v"(hi)); return r; }
DI float wave_sum(float v) {
#pragma unroll
    for (int o = 1; o < 64; o <<= 1) v += __shfl_xor(v, o);
    return v;
}
DI float wave_max(float v) {
#pragma unroll
    for (int o = 1; o < 64; o <<= 1) v = fmaxf(v, __shfl_xor(v, o));
    return v;
}
DI void unpack8(const uint4 v, float* o) { o[0] = bf2f(v.x & 0xffffu); o[1] = bf2f(v.x >> 16); o[2] = bf2f(v.y & 0xffffu); o[3] = bf2f(v.y >> 16); o[4] = bf2f(v.z & 0xffffu); o[5] = bf2f(v.z >> 16); o[6] = bf2f(v.w & 0xffffu); o[7] = bf2f(v.w >> 16); }

#define XB_TMO      128
#define XB_XCNT(j)  (256  + 64 * (j))
#define XB_XSUB(j)  (1280 + 64 * (j))
#define XB_XGEN(j)  (2304 + 64 * (j))
#define XB_TOP      3328
#define XB_TOPGEN   3392
#define XCD_BAR_WORDS 3456
#define XB_SPIN_CAP (1u << 20)
DI unsigned xb_ld(unsigned* p)              { return __hip_atomic_load(p, __ATOMIC_RELAXED, __HIP_MEMORY_SCOPE_AGENT); }
DI unsigned xb_add(unsigned* p, unsigned v) { return __hip_atomic_fetch_add(p, v, __ATOMIC_RELAXED, __HIP_MEMORY_SCOPE_AGENT); }
DI unsigned xb_xcc_id() { return (unsigned)__builtin_amdgcn_s_getreg((3 << 11) | 20) & 0xFu; }
#define XB_SPIN(cond, bar) do { unsigned _sp = 0; while (cond) { __builtin_amdgcn_s_sleep(1); \
    if ((++_sp & 255u) == 0u) { if (xb_ld(&(bar)[XB_TMO])) break; if (_sp > XB_SPIN_CAP) { atomicAdd(&(bar)[XB_TMO], 1u); break; } } } } while (0)
struct XcdBarrier { unsigned* bar; unsigned x; volatile LAS unsigned* st; };
DI XcdBarrier xcd_barrier_post(unsigned* bar, volatile LAS unsigned* st) {
    XcdBarrier b; b.bar = bar; b.x = xb_xcc_id(); b.st = st;
    if (threadIdx.x == 0) (void)xb_add(&bar[XB_XCNT(b.x)], 1u);
    return b;
}
DI void xcd_barrier_complete(unsigned* bar, unsigned x, unsigned& nloc, unsigned& nx) {
    const unsigned G = gridDim.x;
    unsigned sum, cnt, mine, sp = 0u;
    for (;;) {
        sum = 0u; cnt = 0u; mine = 0u;
#pragma unroll
        for (unsigned j = 0; j < 16; ++j) { const unsigned c = xb_ld(&bar[XB_XCNT(j)]); sum += c; cnt += (c > 0u) ? 1u : 0u; mine = (j == x) ? c : mine; }
        if (sum == G) break;
        __builtin_amdgcn_s_sleep(1);
        if ((++sp & 255u) == 0u) { if (xb_ld(&bar[XB_TMO])) break; if (sp > XB_SPIN_CAP) { atomicAdd(&bar[XB_TMO], 1u); break; } }
    }
    nloc = mine > 0u ? mine : 1u; nx = cnt > 0u ? cnt : 1u;
}
DI void xcd_barrier(const XcdBarrier& b) {
    asm volatile("s_waitcnt vmcnt(0)" ::: "memory");
    __syncthreads();
    if (threadIdx.x == 0) {
        unsigned* bar = b.bar;
        __builtin_amdgcn_s_waitcnt(0);
        unsigned nloc = b.st[0], nx = b.st[1];
        if (nloc == 0u) { xcd_barrier_complete(bar, b.x, nloc, nx); b.st[0] = nloc; b.st[1] = nx; }
        const unsigned old = xb_add(&bar[XB_XSUB(b.x)], 1u);
        const unsigned gen = old / nloc;
        if (old + 1u == (gen + 1u) * nloc) {
            __builtin_amdgcn_fence(__ATOMIC_RELEASE, "agent");
            asm volatile("s_waitcnt vmcnt(0)" ::: "memory");
            const unsigned og = xb_add(&bar[XB_TOP], 1u);
            const unsigned tg = og / nx;
            if (og + 1u == (tg + 1u) * nx) xb_add(&bar[XB_TOPGEN], 1u);
            else XB_SPIN(xb_ld(&bar[XB_TOPGEN]) == tg, bar);
            __builtin_amdgcn_fence(__ATOMIC_ACQUIRE, "agent");
            xb_add(&bar[XB_XGEN(b.x)], 1u);
            asm volatile("s_waitcnt vmcnt(0)" ::: "memory");
        } else {
            XB_SPIN(xb_ld(&bar[XB_XGEN(b.x)]) == gen, bar);
            __builtin_amdgcn_fence(__ATOMIC_ACQUIRE, "agent");
            asm volatile("s_waitcnt vmcnt(0)" ::: "memory");
        }
    }
    __syncthreads();
}

namespace pg8 {
constexpr int BM = 256, BK = 64, HALF = 128, HTB = HALF * BK * 2, NXCD = 8, WGM = 2;
DI int lds_byte(int r, int c) { const int st = (r >> 4) * 2 + (c >> 5), rr = r & 15, cc = c & 31, ob = rr * 64 + cc * 2; return st * 1024 + (ob ^ (((ob >> 9) & 1) << 5)); }
DI void stage_rc(int b, int& R, int& C) { const int st = b / 1024, sb = b % 1024, swz = sb ^ (((sb >> 9) & 1) << 5); R = (st >> 1) * 16 + swz / 64; C = (st & 1) * 32 + (swz % 64) / 2; }
DI int perm32(int rho) { const int n = rho >> 4, i = rho & 15; return 8 * (i >> 2) + 4 * n + (i & 3); }
struct Unit { int pm, pn, idx, s; const char* a; const char* b; };
DI void tile_of(int L, int nM, int nN, int& pm, int& pn) {
    const int nwg = nM * nN; int wgid = L;
    { const int q = nwg / NXCD, r = nwg % NXCD, xcd = wgid % NXCD, off = wgid / NXCD; wgid = (xcd < r ? xcd * (q + 1) : r * (q + 1) + (xcd - r) * q) + off; }
    const int nig = WGM * nN, gid = wgid / nig, fm = gid * WGM, gsz = (nM - fm) < WGM ? (nM - fm) : WGM;
    pm = fm + ((wgid % nig) % gsz); pn = (wgid % nig) / gsz;
}
template <class Epi, class Sched, bool ALIGN_EPI>
DI void gemm_phase(LAS unsigned char* lds, const int lda, const int ldb, const int K, const Sched& S, const Epi& E) {
    int tid = threadIdx.x; asm volatile("" : "+v"(tid));
    const int wid = __builtin_amdgcn_readfirstlane(tid >> 6), lane = tid & 63, wr = wid >> 2, wc = wid & 3, fr = lane & 15, fq = lane >> 4;
    const int nt = K / BK;
    unsigned voffA[2], voffB[2];
#pragma unroll
    for (int i = 0; i < 2; ++i) { int R, C; stage_rc(tid * 16 + i * 8192, R, C); const int Rb = (R & ~31) + perm32(R & 31);
        voffA[i] = (unsigned)(R * lda + C) * 2u; voffB[i] = (unsigned)(Rb * ldb + C) * 2u; }
    const size_t kstep = (size_t)(BK * 2);
    const size_t hA = (size_t)HALF * lda * 2, hB = (size_t)HALF * ldb * 2;
    const unsigned ldsw = (unsigned)wid * 1024u;
    const int aoff = lds_byte(wr * 64 + fr, fq * 8), boff = lds_byte(wc * 32 + fr, fq * 8);
#define PG8_SA(b, h) (((b) * 2 + (h)) * HTB)
#define PG8_SB(b, h) ((4 + (b) * 2 + (h)) * HTB)
#define PG8_STAGE(bufoff, gbase, voff) do { _Pragma("unroll") for (int _i = 0; _i < 2; ++_i) \
        __builtin_amdgcn_global_load_lds((const unsigned*)((const char*)(gbase) + (voff)[_i]), (LAS unsigned*)(lds + (bufoff) + ldsw + _i * 8192), 16, 0, 0); } while (0)
#define PG8_LDA(dst, b, h) do { _Pragma("unroll") for (int m = 0; m < 4; ++m) _Pragma("unroll") for (int k = 0; k < 2; ++k) dst[m][k] = *(const LAS bf16x8*)(lds + PG8_SA(b, h) + aoff + m * 2048 + k * 1024); } while (0)
#define PG8_LDB(dst, b, h) do { _Pragma("unroll") for (int n = 0; n < 2; ++n) _Pragma("unroll") for (int k = 0; k < 2; ++k) dst[n][k] = *(const LAS bf16x8*)(lds + PG8_SB(b, h) + boff + n * 2048 + k * 1024); } while (0)
#define PG8_MMA(ai, bj, At, Bt) do { __builtin_amdgcn_s_setprio(1); _Pragma("unroll") for (int m = 0; m < 4; ++m) _Pragma("unroll") for (int n = 0; n < 2; ++n) _Pragma("unroll") for (int k = 0; k < 2; ++k) \
        acc[ai][bj][m][n] = __builtin_amdgcn_mfma_f32_16x16x32_bf16(Bt[n][k], At[m][k], acc[ai][bj][m][n], 0, 0, 0); __builtin_amdgcn_s_setprio(0); } while (0)
#define PG8_WAIT_V(n) asm volatile("s_waitcnt vmcnt(" #n ")" ::: "memory")
#define PG8_WAIT_L(n) asm volatile("s_waitcnt lgkmcnt(" #n ")" ::: "memory")
#define PG8_BAR __builtin_amdgcn_s_barrier()
#define PG8_SCHED __builtin_amdgcn_sched_barrier(0)
    Unit cur, nxt; int ui = 0;
    if (!S.next(0, cur)) return;
    f32x4 acc[2][2][4][2];
#pragma unroll
    for (int a = 0; a < 2; ++a)
#pragma unroll
        for (int b = 0; b < 2; ++b)
#pragma unroll
            for (int m = 0; m < 4; ++m)
#pragma unroll
                for (int n = 0; n < 2; ++n) acc[a][b][m][n] = (f32x4){0.f, 0.f, 0.f, 0.f};
    bf16x8 At[4][2], B0[2][2], B1[2][2];
    const char* cA = cur.a; const char* cB = cur.b;
    PG8_STAGE(PG8_SB(0, 0), cB, voffB); PG8_STAGE(PG8_SB(0, 1), cB + hB, voffB); PG8_STAGE(PG8_SA(0, 0), cA, voffA); PG8_STAGE(PG8_SA(0, 1), cA + hA, voffA);
    if (wr == 1) PG8_BAR;
    PG8_WAIT_V(2); PG8_BAR;
    PG8_STAGE(PG8_SB(1, 0), cB + kstep, voffB); PG8_STAGE(PG8_SA(1, 0), cA + kstep, voffA); PG8_STAGE(PG8_SB(1, 1), cB + hB + kstep, voffB);
    PG8_WAIT_V(6); PG8_BAR;
    for (;;) {
        const bool has_next = S.next(ui + 1, nxt);
        const char* nA = has_next ? nxt.a : cA; const char* nB = has_next ? nxt.b : cB;
        for (int t = 0; t < nt; t += 2) {
            const bool last = (t == nt - 2);
            const char* a1 = cA + (size_t)(t + 1) * kstep;
            const char* a2 = last ? nA : cA + (size_t)(t + 2) * kstep; const char* b2 = last ? nB : cB + (size_t)(t + 2) * kstep;
            const char* a3 = a2 + kstep; const char* b3 = b2 + kstep;
            PG8_LDB(B0, 0, 0); PG8_LDB(B1, 0, 1); PG8_SCHED; PG8_LDA(At, 0, 0); PG8_STAGE(PG8_SA(1, 1), a1 + hA, voffA);
            PG8_WAIT_V(8); PG8_WAIT_L(0); PG8_BAR; PG8_MMA(0, 0, At, B0); PG8_MMA(0, 1, At, B1); PG8_BAR; PG8_SCHED;
            PG8_LDA(At, 0, 1); PG8_STAGE(PG8_SB(0, 0), b2, voffB); PG8_STAGE(PG8_SB(0, 1), b2 + hB, voffB); PG8_STAGE(PG8_SA(0, 0), a2, voffA);
            PG8_WAIT_V(8); PG8_WAIT_L(0); PG8_BAR; PG8_MMA(1, 0, At, B0); PG8_MMA(1, 1, At, B1); PG8_BAR; PG8_SCHED;
            PG8_LDB(B0, 1, 0); PG8_LDB(B1, 1, 1); PG8_SCHED; PG8_LDA(At, 1, 0); PG8_STAGE(PG8_SA(0, 1), a2 + hA, voffA);
            PG8_WAIT_V(8); PG8_WAIT_L(0); PG8_BAR; PG8_MMA(0, 0, At, B0); PG8_MMA(0, 1, At, B1); PG8_BAR; PG8_SCHED;
            PG8_LDA(At, 1, 1); PG8_STAGE(PG8_SB(1, 0), b3, voffB); PG8_STAGE(PG8_SB(1, 1), b3 + hB, voffB); PG8_STAGE(PG8_SA(1, 0), a3, voffA);
            PG8_WAIT_V(8); PG8_WAIT_L(0); PG8_BAR; PG8_MMA(1, 0, At, B0); PG8_MMA(1, 1, At, B1); PG8_BAR; PG8_SCHED;
        }
        if constexpr (ALIGN_EPI) { if (wr == 0) PG8_BAR; }
        if constexpr (!Epi::AFTER_DRAIN) { E(acc, cur, wr, wc, fr, fq); }
        if (!has_next) break;
#pragma unroll
        for (int a = 0; a < 2; ++a)
#pragma unroll
            for (int b = 0; b < 2; ++b)
#pragma unroll
                for (int m = 0; m < 4; ++m)
#pragma unroll
                    for (int n = 0; n < 2; ++n) acc[a][b][m][n] = (f32x4){0.f, 0.f, 0.f, 0.f};
        cur = nxt; cA = nA; cB = nB; ++ui;
        if constexpr (ALIGN_EPI) { if (wr == 1) PG8_BAR; }
    }
    PG8_WAIT_V(0);
    if constexpr (!ALIGN_EPI) { if (wr == 0) PG8_BAR; }
    PG8_BAR;
    if constexpr (Epi::AFTER_DRAIN) { E.fused(acc, cur, wr, wc, fr, fq, lds, wid, lane); }
#undef PG8_SA
#undef PG8_SB
#undef PG8_STAGE
#undef PG8_LDA
#undef PG8_LDB
#undef PG8_MMA
#undef PG8_WAIT_V
#undef PG8_WAIT_L
#undef PG8_BAR
#undef PG8_SCHED
}

struct SchedStd {
    const char* A0; const char* B0; const char* A1; const char* B1; int lda, ldb, nM, nN, G, c, pm_per_batch, dual; size_t bstride;
    DI bool next(int i, Unit& u) const {
        const int ti = dual ? (i >> 1) : i; const long L = (long)ti * G + c; if (L >= (long)nM * nN) return false;
        { int pm_, pn_; tile_of((int)L, nM, nN, pm_, pn_); u.pm = __builtin_amdgcn_readfirstlane(pm_); u.pn = __builtin_amdgcn_readfirstlane(pn_); } u.idx = i; u.s = dual ? (i & 1) : 0;
        const char* A = u.s ? A1 : A0; const char* B = u.s ? B1 : B0;
        u.a = A + (size_t)u.pm * 256 * lda * 2; u.b = B + (size_t)u.pn * 256 * ldb * 2 + (size_t)(u.pm / pm_per_batch) * bstride;
        return true;
    }
};
struct SchedOne {
    int have; Unit u0;
    DI bool next(int i, Unit& u) const { if (i != 0 || !have) return false; u = u0; return true; }
};

DI unsigned cvt_pk_bf16(float lo, float hi) { unsigned r; asm volatile("v_cvt_pk_bf16_f32 %0, %1, %2" : "=v"(r) : "v"(lo), "v"(hi)); return r; }
DI u32x4 pack8(const f32x4 v0, const f32x4 v1) { u32x4 w; w.x = cvt_pk_bf16(v0[0], v0[1]); w.y = cvt_pk_bf16(v0[2], v0[3]); w.z = cvt_pk_bf16(v1[0], v1[1]); w.w = cvt_pk_bf16(v1[2], v1[3]); return w; }
DI float sig1(float v) { return __builtin_amdgcn_rcpf(1.f + __builtin_amdgcn_exp2f(v * -1.4426950408889634f)); }
DI f32x4 sig4(const f32x4 v) { f32x4 o; o[0] = sig1(v[0]); o[1] = sig1(v[1]); o[2] = sig1(v[2]); o[3] = sig1(v[3]); return o; }
DI void up8(const u32x4 w, f32x4& a, f32x4& b) { a[0] = bf2f(w.x & 0xffffu); a[1] = bf2f(w.x >> 16); a[2] = bf2f(w.y & 0xffffu); a[3] = bf2f(w.y >> 16); b[0] = bf2f(w.z & 0xffffu); b[1] = bf2f(w.z >> 16); b[2] = bf2f(w.w & 0xffffu); b[3] = bf2f(w.w >> 16); }
#define EPI_ROWS(...) _Pragma("unroll") for (int ai = 0; ai < 2; ++ai) _Pragma("unroll") for (int m = 0; m < 4; ++m) { const int lr = ai * 128 + wr * 64 + m * 16 + fr; const int row = u.pm * 256 + lr; (void)row; __VA_ARGS__ }
struct EpiBf { static constexpr bool AFTER_DRAIN = false; bf16_t* O; int ld;
    DI void operator()(const f32x4 (&acc)[2][2][4][2], const Unit& u, int wr, int wc, int fr, int fq) const { asm volatile("" : "+v"(fr), "+v"(fq));
        const int c0 = u.pn * 256 + wc * 32 + 8 * fq;
        EPI_ROWS( bf16_t* rp = O + (size_t)row * ld + c0;
            _Pragma("unroll") for (int bj = 0; bj < 2; ++bj) *(u32x4*)(rp + bj * 128) = pack8(acc[ai][bj][m][0], acc[ai][bj][m][1]); )
    } };
struct EpiProj { static constexpr bool AFTER_DRAIN = false; bf16_t* pa; bf16_t* pg;
    DI void operator()(const f32x4 (&acc)[2][2][4][2], const Unit& u, int wr, int wc, int fr, int fq) const { asm volatile("" : "+v"(fr), "+v"(fq));
        const int ct = u.pn * 256; const bool gate = ct >= PA;
        bf16_t* base = gate ? pg + (ct - PA) : pa + ct; const int ld = gate ? PG : PA; const int c0 = wc * 32 + 8 * fq;
        EPI_ROWS( bf16_t* rp = base + (size_t)row * ld + c0;
            _Pragma("unroll") for (int bj = 0; bj < 2; ++bj) { f32x4 v0 = acc[ai][bj][m][0], v1 = acc[ai][bj][m][1]; if (gate) { v0 = sig4(v0); v1 = sig4(v1); }
                *(u32x4*)(rp + bj * 128) = pack8(v0, v1); } )
    } };
struct EpiMerge { static constexpr bool AFTER_DRAIN = false; const bf16_t* pg; bf16_t* scr; bf16_t* mg;
    DI void operator()(const f32x4 (&acc)[2][2][4][2], const Unit& u, int wr, int wc, int fr, int fq) const { asm volatile("" : "+v"(fr), "+v"(fq));
        const int tid = (wr * 4 + wc) * 64 + fq * 16 + fr; bf16_t* my = scr + (size_t)blockIdx.x * 65536 + tid * 8;
        const int c0 = u.pn * 256 + wc * 32 + 8 * fq;
        if (u.s == 0) {
            EPI_ROWS( _Pragma("unroll") for (int bj = 0; bj < 2; ++bj)
                    *(u32x4*)(my + (size_t)((ai * 2 + bj) * 4 + m) * 4096) = pack8(acc[ai][bj][m][0], acc[ai][bj][m][1]); )
        } else {
            EPI_ROWS( _Pragma("unroll") for (int bj = 0; bj < 2; ++bj) {
                    const u32x4 ga = *(const u32x4*)(pg + (size_t)row * PG + c0 + bj * 128), gb = *(const u32x4*)(pg + (size_t)row * PG + 2048 + c0 + bj * 128);
                    const u32x4 tw = *(const u32x4*)(my + (size_t)((ai * 2 + bj) * 4 + m) * 4096);
                    f32x4 a0, a1, b0, b1, t0, t1; up8(ga, a0, a1); up8(gb, b0, b1); up8(tw, t0, t1);
                    *(u32x4*)(mg + (size_t)row * D + c0 + bj * 128) = pack8(a0 * t0 + b0 * acc[ai][bj][m][0], a1 * t1 + b1 * acc[ai][bj][m][1]);
                    asm volatile("" ::: "memory"); } )
        }
    } };
template <bool XI_BF16> struct EpiRes { static constexpr bool AFTER_DRAIN = false; const void* xi; bf16_t* xb; float* part;
    DI void operator()(const f32x4 (&acc)[2][2][4][2], const Unit& u, int wr, int wc, int fr, int fq) const { asm volatile("" : "+v"(fr), "+v"(fq));
        const int c0 = u.pn * 256 + wc * 32 + 8 * fq;
        EPI_ROWS( float ss = 0.f;
            _Pragma("unroll") for (int bj = 0; bj < 2; ++bj) { const size_t off = (size_t)row * D + c0 + bj * 128; f32x4 r0, r1;
                if constexpr (XI_BF16) { const u32x4 w = *(const u32x4*)((const bf16_t*)xi + off); up8(w, r0, r1); }
                else { r0 = *(const f32x4*)((const float*)xi + off); r1 = *(const f32x4*)((const float*)xi + off + 4); }
                const f32x4 v0 = acc[ai][bj][m][0] + r0, v1 = acc[ai][bj][m][1] + r1;
                *(u32x4*)(xb + off) = pack8(v0, v1);
                ss += (v0[0] * v0[0] + v0[1] * v0[1]) + (v0[2] * v0[2] + v0[3] * v0[3]) + (v1[0] * v1[0] + v1[1] * v1[1]) + (v1[2] * v1[2] + v1[3] * v1[3]); }
            ss += __shfl_xor(ss, 16); ss += __shfl_xor(ss, 32);
            if (fq == 0) part[(size_t)row * 32 + u.pn * 4 + wc] = ss;
            asm volatile("" ::: "memory"); )
    } };
struct EpiScore { static constexpr bool AFTER_DRAIN = false; float* S; const LAS float* rtab;
    DI void operator()(const f32x4 (&acc)[2][2][4][2], const Unit& u, int wr, int wc, int fr, int fq) const { asm volatile("" : "+v"(fr), "+v"(fq));
        const int c0 = u.pn * 256 + wc * 32 + 8 * fq;
        EPI_ROWS( const float r = rtab[u.idx * 256 + lr];
            _Pragma("unroll") for (int bj = 0; bj < 2; ++bj) { float* sp = S + (size_t)row * D + c0 + bj * 128;
                *(f32x4*)sp = acc[ai][bj][m][0] * r; *(f32x4*)(sp + 4) = acc[ai][bj][m][1] * r; } )
    } };
struct EpiSoftmax { static constexpr bool AFTER_DRAIN = true; bf16_t* P; const LAS float* rtab;
    DI void fused(f32x4 (&acc)[2][2][4][2], const Unit& u, int wr, int wc, int fr, int fq, LAS unsigned char* lds, int wid, int lane) const { asm volatile("" : "+v"(fr), "+v"(fq));
        LAS f32x2v* X = (LAS f32x2v*)lds;
        const float sc = 0.044194173824159216f * 1.4426950408889634f;
        EPI_ROWS( const float rs = rtab[lr] * sc; float mx = -3.0e38f;
            _Pragma("unroll") for (int bj = 0; bj < 2; ++bj) _Pragma("unroll") for (int n = 0; n < 2; ++n) { f32x4 v = acc[ai][bj][m][n] * rs; acc[ai][bj][m][n] = v; mx = fmaxf(mx, fmaxf(fmaxf(v[0], v[1]), fmaxf(v[2], v[3]))); }
            mx = fmaxf(mx, __shfl_xor(mx, 16)); mx = fmaxf(mx, __shfl_xor(mx, 32)); float sum = 0.f;
            _Pragma("unroll") for (int bj = 0; bj < 2; ++bj) _Pragma("unroll") for (int n = 0; n < 2; ++n) { f32x4 v = acc[ai][bj][m][n];
                v[0] = __builtin_amdgcn_exp2f(v[0] - mx); v[1] = __builtin_amdgcn_exp2f(v[1] - mx); v[2] = __builtin_amdgcn_exp2f(v[2] - mx); v[3] = __builtin_amdgcn_exp2f(v[3] - mx);
                acc[ai][bj][m][n] = v; sum += (v[0] + v[1]) + (v[2] + v[3]); }
            sum += __shfl_xor(sum, 16); sum += __shfl_xor(sum, 32);
            if (fq == 0) X[lr * 4 + wc] = (f32x2v){mx, sum}; )
        asm volatile("s_waitcnt lgkmcnt(0)" ::: "memory"); __builtin_amdgcn_s_barrier(); asm volatile("" ::: "memory");
        const int c0 = u.pn * 256 + wc * 32 + 8 * fq;
        EPI_ROWS( const f32x2v a = X[lr * 4 + 0], b = X[lr * 4 + 1], c = X[lr * 4 + 2], d = X[lr * 4 + 3];
            const float mt = fmaxf(fmaxf(a.x, b.x), fmaxf(c.x, d.x));
            const float lt = a.y * __builtin_amdgcn_exp2f(a.x - mt) + b.y * __builtin_amdgcn_exp2f(b.x - mt) + c.y * __builtin_amdgcn_exp2f(c.x - mt) + d.y * __builtin_amdgcn_exp2f(d.x - mt);
            const float own = (wc == 0) ? a.x : (wc == 1) ? b.x : (wc == 2) ? c.x : d.x;
            const float f = __builtin_amdgcn_exp2f(own - mt) * __builtin_amdgcn_rcpf(lt);
            bf16_t* rp = P + (size_t)row * 1024 + c0;
            _Pragma("unroll") for (int bj = 0; bj < 2; ++bj) *(u32x4*)(rp + bj * 128) = pack8(acc[ai][bj][m][0] * f, acc[ai][bj][m][1] * f); )
        asm volatile("s_waitcnt lgkmcnt(0)" ::: "memory"); __builtin_amdgcn_s_barrier();
    } };
}

struct Frame {
    LAS unsigned char* lds; unsigned char* ldsg;
    int tid, lane, wave, vcu, G, gw, NGW;
};
struct Args { const float* in[22]; float* out; unsigned char* ws; };
#define WB(off) ((bf16_t*)(args.ws + (off)))
#define WF(off) ((float*)(args.ws + (off)))

DI void p0_transpose_item(const float* W, int K, int N, bf16_t* WT, int row_off, float* scr, int item, int lane) {
    const int nblk = N / 32, kb = item / nblk, nb = item % nblk, k0 = 64 * kb, n0 = 32 * nb;
#pragma unroll 8
    for (int i = 0; i < 32; ++i) { const int kk = 2 * i + (lane >> 5); scr[kk * 33 + (lane & 31)] = W[(size_t)(k0 + kk) * N + n0 + (lane & 31)]; }
    asm volatile("s_waitcnt lgkmcnt(0)" ::: "memory");
    const int c = lane & 7;
#pragma unroll
    for (int j = 0; j < 4; ++j) { const int n = (lane >> 3) + 8 * j; const float* s = scr + (8 * c) * 33 + n;
        uint4 o; o.x = pk2(s[0 * 33], s[1 * 33]); o.y = pk2(s[2 * 33], s[3 * 33]); o.z = pk2(s[4 * 33], s[5 * 33]); o.w = pk2(s[6 * 33], s[7 * 33]);
        *(uint4*)(WT + (size_t)(row_off + n0 + n) * K + k0 + 8 * c) = o; }
    asm volatile("s_waitcnt lgkmcnt(0)" ::: "memory");
}
DI void convert_rows(Frame& F, const float* W, const float* g, bf16_t* O, int rows, int cols) {
    const size_t n8 = (size_t)rows * cols / 8;
    for (size_t i = (size_t)F.vcu * NTHR + F.tid; i < n8; i += (size_t)F.G * NTHR) {
        const size_t e = i * 8; const float s = g ? g[(int)(e / cols)] : 1.f;
        const float4 a = *(const float4*)(W + e), b = *(const float4*)(W + e + 4);
        uint4 o; o.x = pk2(a.x * s, a.y * s); o.y = pk2(a.z * s, a.w * s); o.z = pk2(b.x * s, b.y * s); o.w = pk2(b.z * s, b.w * s);
        *(uint4*)(O + e) = o;
    }
}
DI void rmsnorm_rows(Frame& F, const float* X, const float* g, bf16_t* O, int rows) {
    for (int row = F.gw; row < rows; row += F.NGW) {
        const float4* xr = (const float4*)(X + (size_t)row * D) + F.lane;
        float4 v[8]; float s = 0.f;
#pragma unroll
        for (int j = 0; j < 8; ++j) { v[j] = xr[64 * j]; s += v[j].x * v[j].x + v[j].y * v[j].y + v[j].z * v[j].z + v[j].w * v[j].w; }
        const float r = rsqrtf(wave_sum(s) * (1.f / D) + EPS);
        uint2* o = (uint2*)(O + (size_t)row * D) + F.lane;
#pragma unroll
        for (int j = 0; j < 8; ++j) { const float4 gg = ((const float4*)g)[F.lane + 64 * j];
            uint2 w; w.x = pk2(v[j].x * r * gg.x, v[j].y * r * gg.y); w.y = pk2(v[j].z * r * gg.z, v[j].w * r * gg.w); o[64 * j] = w; }
    }
}
DI void p0_prologue(Frame& F, const Args& args) {
    float* scr = (float*)(F.ldsg + F.wave * 16384);
    constexpr int I_IN = 32 * 320, I_AT = 16 * 64, I_SQ = 32 * 64;
    constexpr int NITEMS = I_IN + 2 * I_AT + 4 * I_SQ;
    for (int it = F.gw; it < NITEMS; it += F.NGW) {
        int r = it;
        if (r < I_IN) { p0_transpose_item(args.in[3], 2048, INC, WB(WS_WINT), 0, scr, r, F.lane); continue; } r -= I_IN;
        if (r < I_AT) { p0_transpose_item(args.in[7], 1024, 2048, WB(WS_WATT), 0, scr, r, F.lane); continue; } r -= I_AT;
        if (r < I_AT) { p0_transpose_item(args.in[8], 1024, 2048, WB(WS_WCONV), 0, scr, r, F.lane); continue; } r -= I_AT;
        if (r < I_SQ) { p0_transpose_item(args.in[9], 2048, 2048, WB(WS_WMIX), 0, scr, r, F.lane); continue; } r -= I_SQ;
        if (r < I_SQ) { p0_transpose_item(args.in[13], 2048, 2048, WB(WS_WKVT), 0, scr, r, F.lane); continue; } r -= I_SQ;
        if (r < I_SQ) { p0_transpose_item(args.in[14], 2048, 2048, WB(WS_WKVT), 2048, scr, r, F.lane); continue; } r -= I_SQ;
        p0_transpose_item(args.in[15], 2048, 2048, WB(WS_WCOT), 0, scr, r, F.lane);
    }
    convert_rows(F, args.in[12], args.in[10], WB(WS_WCQN), 2048, 2048);
    convert_rows(F, args.in[17], args.in[16], WB(WS_WPQN), 2048, 2048);
    for (int i = F.vcu * NTHR + F.tid; i < 2048 * 32; i += F.G * NTHR) {
        const int r = i >> 5, c8 = (i & 31) * 8, g = r >> 7; uint4 o = make_uint4(0u, 0u, 0u, 0u);
        if ((c8 >> 7) == (g & 1)) { const float* sp = args.in[18] + (size_t)r * 128 + (c8 & 127); const float4 a = *(const float4*)sp, b = *(const float4*)(sp + 4);
            o.x = pk2(a.x, a.y); o.y = pk2(a.z, a.w); o.z = pk2(b.x, b.y); o.w = pk2(b.z, b.w); }
        *(uint4*)(WB(WS_AKEYS) + (size_t)r * 256 + c8) = o;
    }
    rmsnorm_rows(F, args.in[0], args.in[2], WB(WS_H1), M);
    rmsnorm_rows(F, args.in[1], args.in[11], WB(WS_MEMN), MROWS);
}

typedef float f32x16 __attribute__((ext_vector_type(16)));
typedef short v4i16_t __attribute__((ext_vector_type(4)));
constexpr int BA_KROW = 272, BA_VROW = 320, BA_KSZ = 64 * BA_KROW, BA_BUF = BA_KSZ + 64 * BA_VROW, BA_TAB = 2 * BA_BUF;
DI int crow(int r, int hi) { return (r & 3) + 8 * (r >> 2) + 4 * hi; }
DI unsigned cvtpk(float lo, float hi) { unsigned r; asm volatile("v_cvt_pk_bf16_f32 %0, %1, %2" : "=v"(r) : "v"(lo), "v"(hi)); return r; }
DI bf16x8 pack_frag(const f32x16& p, int b) { u32x4 w; w.x = cvtpk(p[b], p[b + 1]); w.y = cvtpk(p[b + 2], p[b + 3]); w.z = cvtpk(p[b + 4], p[b + 5]); w.w = cvtpk(p[b + 6], p[b + 7]); return __builtin_bit_cast(bf16x8, w); }
DI void battn_unit(LAS unsigned char* lds, const bf16_t* __restrict__ pa, const float* __restrict__ relb, bf16_t* __restrict__ oatt, int unit) {
    int tid = threadIdx.x; asm volatile("" : "+v"(tid)); const int lane = tid & 63, wave = __builtin_amdgcn_readfirstlane(tid >> 6);
    const int cg = unit & 15, h = (unit >> 4) & 7, b = unit >> 7;
    const int c = cg * 4 + (wave >> 1), r32 = lane & 31, hi = lane >> 5, a = 32 * (wave & 1) + r32;
    const int tok = b * SEQ + c * 64 + a;
    const float LOG2E = 1.4426950408889634f, SC = 0.08838834764831845f * LOG2E;
    LAS float* tab = (LAS float*)(lds + BA_TAB);
    for (int i = tid; i < 257; i += NTHR) tab[i] = relb[h * 257 + i] * LOG2E;
    bf16x8 qf[8];
    { const bf16_t* qp = pa + (size_t)tok * PA + h * 128 + 8 * hi;
#pragma unroll
      for (int ks = 0; ks < 8; ++ks) qf[ks] = *(const bf16x8*)(qp + ks * 16); }
    f32x16 o0 = {}, o1 = {}, o2 = {}, o3 = {};
    float m = -1.0e30f, l = 0.f;
    const int src0 = cg * 4 - 8, first = src0 < 0 ? -src0 : 0;
    u32x4 kr0, kr1, vr0, vr1;
    const int key0 = tid >> 4, part = tid & 15;
    const bf16_t* gbase = pa + (size_t)(b * SEQ + key0) * PA + h * 128 + part * 8;
#define BA_GLOAD(src) do { const bf16_t* rp_ = gbase + (size_t)(src) * 64 * PA; kr0 = *(const u32x4*)(rp_ + 1024); vr0 = *(const u32x4*)(rp_ + 2048); \
        kr1 = *(const u32x4*)(rp_ + (size_t)32 * PA + 1024); vr1 = *(const u32x4*)(rp_ + (size_t)32 * PA + 2048); } while (0)
    BA_GLOAD(src0 + first);
    int buf = 0;
    const int vlane = (4 * hi + ((lane & 15) >> 2)) * BA_VROW + (16 * ((lane >> 4) & 1) + 4 * (lane & 3)) * 2;
    for (int kt = first; kt < 12; ++kt) {
        const int src = src0 + kt;
        LAS unsigned char* Kb = lds + buf * BA_BUF; LAS unsigned char* Vb = Kb + BA_KSZ;
        *(LAS u32x4*)(Kb + key0 * BA_KROW + part * 16) = kr0; *(LAS u32x4*)(Kb + (key0 + 32) * BA_KROW + part * 16) = kr1;
        *(LAS u32x4*)(Vb + key0 * BA_VROW + part * 16) = vr0; *(LAS u32x4*)(Vb + (key0 + 32) * BA_VROW + part * 16) = vr1;
        if (kt + 1 < 12) BA_GLOAD(src + 1);
        __syncthreads();
        const int dc = c - src;
        if (dc >= 0 && dc <= 8) {
            f32x16 p0 = {}, p1 = {};
            const LAS unsigned char* kp = Kb + r32 * BA_KROW + hi * 16;
#pragma unroll
            for (int ks = 0; ks < 8; ++ks) {
                const bf16x8 k0 = *(const LAS bf16x8*)(kp + ks * 32), k1 = *(const LAS bf16x8*)(kp + 32 * BA_KROW + ks * 32);
                p0 = __builtin_amdgcn_mfma_f32_32x32x16_bf16(k0, qf[ks], p0, 0, 0, 0);
                p1 = __builtin_amdgcn_mfma_f32_32x32x16_bf16(k1, qf[ks], p1, 0, 0, 0);
            }
            if (dc >= 3) { const float bc = tab[256];
#pragma unroll
                for (int r = 0; r < 16; ++r) { p0[r] = p0[r] * SC + bc; p1[r] = p1[r] * SC + bc; }
            } else { const int rb = dc * 64 + a + 128;
#pragma unroll
                for (int r = 0; r < 16; ++r) { const int i0 = rb - crow(r, hi), i1 = i0 - 32;
                    p0[r] = p0[r] * SC + tab[i0 > 256 ? 256 : i0]; p1[r] = p1[r] * SC + tab[i1 > 256 ? 256 : i1]; }
            }
            float mx = fmaxf(p0[0], p1[0]);
#pragma unroll
            for (int r = 1; r < 16; ++r) mx = fmaxf(mx, fmaxf(p0[r], p1[r]));
            mx = fmaxf(mx, __shfl_xor(mx, 32));
            const float mn = fmaxf(m, mx), alpha = __builtin_amdgcn_exp2f(m - mn); m = mn;
            float ls = 0.f;
#pragma unroll
            for (int r = 0; r < 16; ++r) { p0[r] = __builtin_amdgcn_exp2f(p0[r] - mn); p1[r] = __builtin_amdgcn_exp2f(p1[r] - mn); ls += p0[r] + p1[r]; }
            l = l * alpha + ls;
            o0 *= alpha; o1 *= alpha; o2 *= alpha; o3 *= alpha;
            bf16x8 pf[4]; pf[0] = pack_frag(p0, 0); pf[1] = pack_frag(p0, 8); pf[2] = pack_frag(p1, 0); pf[3] = pack_frag(p1, 8);
            const LAS unsigned char* vl = Vb + vlane;
#pragma unroll
            for (int s4 = 0; s4 < 4; ++s4) {
#define BA_VF(db) ({ const v4i16_t lo_ = __builtin_amdgcn_ds_read_tr16_b64_v4i16((LAS v4i16_t*)(vl + s4 * 16 * BA_VROW + (db) * 64)); \
                     const v4i16_t hi_ = __builtin_amdgcn_ds_read_tr16_b64_v4i16((LAS v4i16_t*)(vl + s4 * 16 * BA_VROW + 8 * BA_VROW + (db) * 64)); \
                     (bf16x8){lo_[0], lo_[1], lo_[2], lo_[3], hi_[0], hi_[1], hi_[2], hi_[3]}; })
                o0 = __builtin_amdgcn_mfma_f32_32x32x16_bf16(BA_VF(0), pf[s4], o0, 0, 0, 0);
                o1 = __builtin_amdgcn_mfma_f32_32x32x16_bf16(BA_VF(1), pf[s4], o1, 0, 0, 0);
                o2 = __builtin_amdgcn_mfma_f32_32x32x16_bf16(BA_VF(2), pf[s4], o2, 0, 0, 0);
                o3 = __builtin_amdgcn_mfma_f32_32x32x16_bf16(BA_VF(3), pf[s4], o3, 0, 0, 0);
#undef BA_VF
            }
        }
        buf ^= 1;
    }
#undef BA_GLOAD
    const float inv = __builtin_amdgcn_rcpf(l + __shfl_xor(l, 32));
    bf16_t* op = oatt + (size_t)tok * 1024 + h * 128 + 4 * hi;
#define BA_ST(o, db) do { _Pragma("unroll") for (int rg = 0; rg < 4; ++rg) { uint2 w_; w_.x = cvtpk(o[4 * rg] * inv, o[4 * rg + 1] * inv); w_.y = cvtpk(o[4 * rg + 2] * inv, o[4 * rg + 3] * inv); \
        *(uint2*)(op + (db) * 32 + 8 * rg) = w_; } } while (0)
    BA_ST(o0, 0); BA_ST(o1, 1); BA_ST(o2, 2); BA_ST(o3, 3);
#undef BA_ST
    __syncthreads();
}
DI void ld8bf(const bf16_t* p, float* o) { unpack8(*(const uint4*)p, o); }
DI void conv_item(const bf16_t* __restrict__ pa, const float* __restrict__ cw, const float* __restrict__ cb, bf16_t* __restrict__ yc, int gid) {
    const int cg = gid & 127, tb = gid >> 7, c0 = cg * 8, t0 = tb * 16;
    float w0[8], w1[8], w2[8], bb[8], m1[8], m2[8];
#pragma unroll
    for (int j = 0; j < 8; ++j) { w0[j] = cw[c0 + j]; w1[j] = cw[1024 + c0 + j]; w2[j] = cw[2048 + c0 + j]; bb[j] = cb[c0 + j]; m1[j] = 0.f; m2[j] = 0.f; }
    if ((t0 & (SEQ - 1)) != 0) {
        float u[8], c[8];
        ld8bf(pa + (size_t)(t0 - 2) * PA + 3072 + c0, u); ld8bf(pa + (size_t)(t0 - 2) * PA + 5120 + c0, c);
#pragma unroll
        for (int j = 0; j < 8; ++j) m2[j] = u[j] * c[j];
        ld8bf(pa + (size_t)(t0 - 1) * PA + 3072 + c0, u); ld8bf(pa + (size_t)(t0 - 1) * PA + 5120 + c0, c);
#pragma unroll
        for (int j = 0; j < 8; ++j) m1[j] = u[j] * c[j];
    }
    for (int t = t0; t < t0 + 16; ++t) {
        float u[8], c[8], g[8], y[8];
        ld8bf(pa + (size_t)t * PA + 3072 + c0, u); ld8bf(pa + (size_t)t * PA + 5120 + c0, c); ld8bf(pa + (size_t)t * PA + 4096 + c0, g);
#pragma unroll
        for (int j = 0; j < 8; ++j) { const float cu = u[j] * c[j]; y[j] = g[j] * (bb[j] + w0[j] * m2[j] + w1[j] * m1[j] + w2[j] * cu); m2[j] = m1[j]; m1[j] = cu; }
        uint4 o; o.x = pk2(y[0], y[1]); o.y = pk2(y[2], y[3]); o.z = pk2(y[4], y[5]); o.w = pk2(y[6], y[7]);
        *(uint4*)(yc + (size_t)t * 1024 + c0) = o;
    }
}

DI unsigned f2key(float f) { const unsigned u = __float_as_uint(f); return u ^ ((unsigned)((int)u >> 31) | 0x80000000u); }
DI float key2f(unsigned s) { return __uint_as_float(s ^ ((unsigned)((int)(~s) >> 31) | 0x80000000u)); }
#define INS16(T, key) do { unsigned v_ = (key); _Pragma("unroll") for (int q_ = 0; q_ < 16; ++q_) { const unsigned t_ = T[q_] > v_ ? T[q_] : v_; v_ = T[q_] > v_ ? v_ : T[q_]; T[q_] = t_; } } while (0)
DI void topk_item4(const float* __restrict__ scores, int* __restrict__ idx, float* __restrict__ gate, int item, LAS unsigned char* wl, int lane) {
    const float* sp = scores + (size_t)item * 4 * D;
    unsigned top[16];
#pragma unroll
    for (int i = 0; i < 16; ++i) top[i] = 0u;
#pragma unroll 1
    for (int h = 0; h < 2; ++h) {
#pragma unroll
        for (int i = 0; i < 16; ++i) { const int grp = i * 4 + (lane >> 4), piece = lane & 15;
            const f32x4 v = *(const f32x4*)(sp + grp * 128 + h * 64 + piece * 4);
            *(LAS f32x4*)(wl + grp * 272 + piece * 16) = v; }
        asm volatile("s_waitcnt vmcnt(0) lgkmcnt(0)" ::: "memory");
#pragma unroll 4
        for (int j = 0; j < 16; ++j) { const f32x4 v = *(const LAS f32x4*)(wl + lane * 272 + j * 16);
#pragma unroll
            for (int e = 0; e < 4; ++e) INS16(top, (f2key(v[e]) & ~127u) | (unsigned)(h * 64 + j * 4 + e)); }
        asm volatile("s_waitcnt lgkmcnt(0)" ::: "memory");
    }
    const int p = lane & 1;
    unsigned L1[16], L2[16]; float v1[16], v2[16];
#pragma unroll
    for (int i = 0; i < 16; ++i) { const unsigned pt = __shfl_xor(top[i], 1); L1[i] = p ? pt : top[i]; L2[i] = p ? top[i] : pt; v1[i] = key2f(L1[i] & ~127u); v2[i] = key2f(L2[i] & ~127u); }
    unsigned ct[16];
#pragma unroll
    for (int i = 0; i < 16; ++i) ct[i] = 0u;
#pragma unroll
    for (int i = 0; i < 16; ++i)
#pragma unroll
        for (int j = 0; j < 16; ++j) if ((i + 1) * (j + 1) <= 16) INS16(ct, (f2key(v1[i] + v2[j]) & ~255u) | (unsigned)(i * 16 + j));
    const float mx = key2f(ct[0] & ~255u); float sum = 0.f;
#pragma unroll
    for (int t = 0; t < 16; ++t) sum += __expf(key2f(ct[t] & ~255u) - mx);
    const float isum = __builtin_amdgcn_rcpf(sum);
    const int tl = lane >> 4, head = (lane & 15) >> 1;
    const size_t ob = (size_t)(item * 4 + tl) * 128 + head * 16 + p * 8;
    { u32x4 w1, w2;
#define PK4(L, b) ((L[b] & 127u) | ((L[b + 1] & 127u) << 8) | ((L[b + 2] & 127u) << 16) | ((L[b + 3] & 127u) << 24))
      w1.x = PK4(L1, 0); w1.y = PK4(L1, 4); w1.z = PK4(L1, 8); w1.w = PK4(L1, 12); w2.x = PK4(L2, 0); w2.y = PK4(L2, 4); w2.z = PK4(L2, 8); w2.w = PK4(L2, 12);
#undef PK4
      *(LAS u32x4*)(wl + lane * 272) = w1; *(LAS u32x4*)(wl + lane * 272 + 16) = w2; }
    asm volatile("s_waitcnt lgkmcnt(0)" ::: "memory");
    int ev[8]; float gv[8];
#pragma unroll
    for (int t = 0; t < 8; ++t) { const unsigned ck = ct[t] ^ ((ct[t] ^ ct[8 + t]) & (0u - (unsigned)p));
        const unsigned i1 = *(const LAS unsigned char*)(wl + lane * 272 + ((ck >> 4) & 15u)), i2 = *(const LAS unsigned char*)(wl + lane * 272 + 16 + (ck & 15u));
        ev[t] = (int)(i1 * 128u + i2);
        gv[t] = __expf(key2f(ck & ~255u) - mx) * isum; }
    asm volatile("s_waitcnt lgkmcnt(0)" ::: "memory");
    *(int4*)(idx + ob) = make_int4(ev[0], ev[1], ev[2], ev[3]); *(int4*)(idx + ob + 4) = make_int4(ev[4], ev[5], ev[6], ev[7]);
    *(float4*)(gate + ob) = make_float4(gv[0], gv[1], gv[2], gv[3]); *(float4*)(gate + ob + 4) = make_float4(gv[4], gv[5], gv[6], gv[7]);
}

typedef float v2f __attribute__((ext_vector_type(2)));
DI float gelu_exact(float x) { return 0.5f * x * (1.f + erff(x * 0.70710678118654752f)); }
typedef unsigned u32x6 __attribute__((ext_vector_type(6)));
typedef unsigned u32x2 __attribute__((ext_vector_type(2)));
typedef float f32x32 __attribute__((ext_vector_type(32)));
constexpr int FP6_ROW = 1536;
DI unsigned fp6_code(float x) {
    const float a = fminf(fabsf(x), 7.5f);
    unsigned c = a < 1.f ? (unsigned)__builtin_rintf(a * 8.f) : ((__float_as_uint(a) + 0x80000u) >> 20) - 1008u;
    c = c > 31u ? 31u : c;
    return c | ((__float_as_uint(x) >> 26) & 32u);
}
typedef float f32x16 __attribute__((ext_vector_type(16)));
DI void fp6_encode_row(const f32x4 (&v)[8], float mx, unsigned char* __restrict__ dst, float* __restrict__ inv, int row, int lane) {
    int k = 2 - ((int)((__float_as_uint(mx) >> 23) & 255u) - 127); k = k > 100 ? 100 : (k < -100 ? -100 : k);
    const float sc = __uint_as_float((unsigned)(127 + k) << 23), isc = __uint_as_float((unsigned)(127 - k) << 23);
    f32x16 a, b;
#pragma unroll
    for (int i = 0; i < 16; ++i) { a[i] = v[(2 * i) >> 2][(2 * i) & 3] * sc; b[i] = v[(2 * i + 1) >> 2][(2 * i + 1) & 3] * sc; }
    const u32x6 w = __builtin_amdgcn_cvt_scalef32_2xpk16_fp6_f32(a, b, 1.0f);
    unsigned char* op = dst + ((size_t)(lane >> 3) * NEXP + row) * 192 + (lane & 7) * 24;
    *(u32x2*)op = (u32x2){w[0], w[1]}; *(u32x2*)(op + 8) = (u32x2){w[2], w[3]}; *(u32x2*)(op + 16) = (u32x2){w[4], w[5]};
    if (lane == 0) inv[row] = isc;
}
DI void convert_fp6_rows(Frame& F, const float* __restrict__ src, unsigned char* __restrict__ dst, float* __restrict__ inv, int rows, int wv, int nw, LAS unsigned char* wl) {
    if (wv >= rows) return;
    f32x4 v[8];
    { const float* rp = src + (size_t)wv * D + F.lane * 4;
#pragma unroll
      for (int q = 0; q < 8; ++q) v[q] = *(const f32x4*)(rp + q * 256); }
    for (int row = wv; row < rows; row += nw) {
        float mx = 0.f;
#pragma unroll
        for (int q = 0; q < 8; ++q) { const f32x4 t = v[q]; mx = fmaxf(mx, fmaxf(fmaxf(fabsf(t[0]), fabsf(t[1])), fmaxf(fabsf(t[2]), fabsf(t[3]))));
            const int c = (q * 64 + F.lane) * 4; *(LAS f32x4*)(wl + (c + 4 * (c >> 5)) * 4) = t; }
        { const int nr = row + nw < rows ? row + nw : row; const float* rp = src + (size_t)nr * D + F.lane * 4;
#pragma unroll
          for (int q = 0; q < 8; ++q) v[q] = *(const f32x4*)(rp + q * 256); }
        mx = wave_max(mx);
        asm volatile("s_waitcnt lgkmcnt(0)" ::: "memory");
        f32x4 r[8];
#pragma unroll
        for (int i = 0; i < 8; ++i) r[i] = *(const LAS f32x4*)(wl + (36 * F.lane + 4 * i) * 4);
        asm volatile("s_waitcnt lgkmcnt(0)" ::: "memory");
        fp6_encode_row(r, mx, dst, inv, row, F.lane);
    }
}
typedef __bf16 bf16x32_t __attribute__((ext_vector_type(32)));
typedef __bf16 bf16x2_t __attribute__((ext_vector_type(2)));
constexpr int FP6_SLICE = 192;
DI void peer_u_round(LAS unsigned char* wl, const bf16_t* __restrict__ x2b, const float* __restrict__ part2, const float* __restrict__ gpeer, const int* __restrict__ idx,
                     const unsigned char* __restrict__ eu, float* __restrict__ pd, int t0, int x, int lane) {
    asm volatile("" : "+v"(lane));
    const int g = lane >> 3, l8 = lane & 7, tok = t0 + g;
    LAS int* lidx = (LAS int*)wl;
#pragma unroll
    for (int i = 0; i < 4; ++i) *(LAS u32x4*)(wl + (i * 64 + lane) * 16) = *(const u32x4*)(idx + (size_t)t0 * 128 + (i * 64 + lane) * 4);
    float ss = 0.f;
    { const f32x4 p = *(const f32x4*)(part2 + (size_t)tok * 32 + l8 * 4); ss = (p[0] + p[1]) + (p[2] + p[3]); }
    ss += __shfl_xor(ss, 1); ss += __shfl_xor(ss, 2); ss += __shfl_xor(ss, 4);
    const float r = rsqrtf(ss * (1.f / D) + EPS);
    bf16x2_t hb[16];
    const int c0 = x * 256 + l8 * 32;
#pragma unroll
    for (int q = 0; q < 4; ++q) { const u32x4 w = *(const u32x4*)(x2b + (size_t)tok * D + c0 + q * 8); f32x4 a, b; pg8::up8(w, a, b);
        const f32x4 ga = *(const f32x4*)(gpeer + c0 + q * 8), gb = *(const f32x4*)(gpeer + c0 + q * 8 + 4);
        a = a * ga * r; b = b * gb * r;
        hb[q * 4] = __builtin_bit_cast(bf16x2_t, pg8::cvt_pk_bf16(a[0], a[1])); hb[q * 4 + 1] = __builtin_bit_cast(bf16x2_t, pg8::cvt_pk_bf16(a[2], a[3]));
        hb[q * 4 + 2] = __builtin_bit_cast(bf16x2_t, pg8::cvt_pk_bf16(b[0], b[1])); hb[q * 4 + 3] = __builtin_bit_cast(bf16x2_t, pg8::cvt_pk_bf16(b[2], b[3])); }
    asm volatile("s_waitcnt lgkmcnt(0)" ::: "memory");
    const unsigned char* ub = eu + (size_t)x * NEXP * FP6_SLICE + l8 * 24;
    float* pdo = pd + ((size_t)x * M + tok) * 128 + l8;
#define PU_LOAD(UU, j0) do { _Pragma("unroll") for (int jj = 0; jj < 8; ++jj) { const int e_ = lidx[g * 128 + (j0) + jj]; const unsigned char* up_ = ub + (size_t)e_ * FP6_SLICE; \
        const u32x4 ua_ = *(const u32x4*)up_; const u32x2 uc_ = *(const u32x2*)(up_ + 16); UU[jj] = (u32x6){ua_[0], ua_[1], ua_[2], ua_[3], uc_[0], uc_[1]}; } } while (0)
#define PU_COMP(UU, j0) do { float p[8]; \
        _Pragma("unroll") for (int jj = 0; jj < 8; ++jj) { const bf16x32_t uf = __builtin_amdgcn_cvt_scalef32_pk32_bf16_fp6(UU[jj], 1.0f); float a0 = 0.f, a1 = 0.f; \
            _Pragma("unroll") for (int k = 0; k < 16; k += 2) { a0 = __builtin_amdgcn_fdot2_f32_bf16((bf16x2_t){uf[2 * k], uf[2 * k + 1]}, hb[k], a0, false); \
                a1 = __builtin_amdgcn_fdot2_f32_bf16((bf16x2_t){uf[2 * k + 2], uf[2 * k + 3]}, hb[k + 1], a1, false); } \
            p[jj] = a0 + a1; __builtin_amdgcn_sched_barrier(0); } \
        const bool b0 = l8 & 1, b1 = l8 & 2, b2 = l8 & 4; \
        float q0 = (b0 ? p[1] : p[0]) + __shfl_xor(b0 ? p[0] : p[1], 1), q1 = (b0 ? p[3] : p[2]) + __shfl_xor(b0 ? p[2] : p[3], 1); \
        float q2 = (b0 ? p[5] : p[4]) + __shfl_xor(b0 ? p[4] : p[5], 1), q3 = (b0 ? p[7] : p[6]) + __shfl_xor(b0 ? p[6] : p[7], 1); \
        const float r0 = (b1 ? q1 : q0) + __shfl_xor(b1 ? q0 : q1, 2), r1 = (b1 ? q3 : q2) + __shfl_xor(b1 ? q2 : q3, 2); \
        pdo[j0] = (b2 ? r1 : r0) + __shfl_xor(b2 ? r0 : r1, 4); } while (0)
    u32x6 UA[8], UB[8];
    PU_LOAD(UA, 0);
#pragma unroll 1
    for (int j0 = 0; j0 < 112; j0 += 16) {
        PU_LOAD(UB, j0 + 8);
        PU_COMP(UA, j0);
        PU_LOAD(UA, j0 + 16);
        PU_COMP(UB, j0 + 8);
    }
    PU_LOAD(UB, 120);
    PU_COMP(UA, 112);
    PU_COMP(UB, 120);
#undef PU_LOAD
#undef PU_COMP
    asm volatile("s_waitcnt lgkmcnt(0)" ::: "memory");
}
DI void peer_act(Frame& F, const float* __restrict__ pd, const int* __restrict__ idx, const float* __restrict__ gate, const float* __restrict__ scu, const float* __restrict__ scv, float* __restrict__ act) {
    for (size_t i = (size_t)F.vcu * NTHR + F.tid; i < (size_t)M * 128; i += (size_t)F.G * NTHR) {
        float s = 0.f;
#pragma unroll
        for (int x = 0; x < 8; ++x) s += pd[(size_t)x * M * 128 + i];
        const int e = idx[i];
        act[i] = gelu_exact(s * scu[e]) * gate[i] * scv[e];
    }
}
DI void peer_v_round(LAS unsigned char* wl, const bf16_t* __restrict__ x2b, const int* __restrict__ idx, const float* __restrict__ act, const unsigned char* __restrict__ ev,
                     bf16_t* __restrict__ yb, float* __restrict__ ssq, int t0, int x, int lane) {
    asm volatile("" : "+v"(lane));
    const int g = lane >> 3, l8 = lane & 7, tok = t0 + g;
    LAS int* lidx = (LAS int*)wl; LAS float* lact = (LAS float*)(wl + 4096);
#pragma unroll
    for (int i = 0; i < 4; ++i) { *(LAS u32x4*)(wl + (i * 64 + lane) * 16) = *(const u32x4*)(idx + (size_t)t0 * 128 + (i * 64 + lane) * 4);
        *(LAS f32x4*)(wl + 4096 + (i * 64 + lane) * 16) = *(const f32x4*)(act + (size_t)t0 * 128 + (i * 64 + lane) * 4); }
    f32x32 o;
#pragma unroll
    for (int k = 0; k < 32; ++k) o[k] = 0.f;
    asm volatile("s_waitcnt vmcnt(0) lgkmcnt(0)" ::: "memory");
    const unsigned char* vb = ev + (size_t)x * NEXP * FP6_SLICE + l8 * 24;
#define PV_LOAD(VB, j0) do { _Pragma("unroll") for (int jj = 0; jj < 4; ++jj) { const int e_ = lidx[g * 128 + (j0) + jj]; \
        const unsigned char* vp_ = vb + (size_t)e_ * FP6_SLICE; const u32x4 va_ = *(const u32x4*)vp_; const u32x2 vc_ = *(const u32x2*)(vp_ + 16); \
        VB[jj] = (u32x6){va_[0], va_[1], va_[2], va_[3], vc_[0], vc_[1]}; } } while (0)
#define PV_ACC(VB, j0) do { _Pragma("unroll") for (int jj = 0; jj < 4; ++jj) { const f32x32 vf_ = __builtin_amdgcn_cvt_scalef32_pk32_f32_fp6(VB[jj], 1.0f); \
        o += vf_ * lact[g * 128 + (j0) + jj]; __builtin_amdgcn_sched_barrier(0); } } while (0)
    u32x6 vA[4], vB[4];
    PV_LOAD(vA, 0);
#pragma unroll 1
    for (int j0 = 0; j0 < 120; j0 += 8) {
        PV_LOAD(vB, j0 + 4);
        PV_ACC(vA, j0);
        PV_LOAD(vA, j0 + 8);
        PV_ACC(vB, j0 + 4);
    }
    PV_LOAD(vB, 124);
    PV_ACC(vA, 120);
    PV_ACC(vB, 124);
#undef PV_LOAD
#undef PV_ACC
    const int c0 = x * 256 + l8 * 32; float ss = 0.f;
#pragma unroll
    for (int q = 0; q < 4; ++q) { const u32x4 w = *(const u32x4*)(x2b + (size_t)tok * D + c0 + q * 8); f32x4 ta, tb; pg8::up8(w, ta, tb);
        const f32x4 ya = {o[q * 8] + ta[0], o[q * 8 + 1] + ta[1], o[q * 8 + 2] + ta[2], o[q * 8 + 3] + ta[3]}, yb_ = {o[q * 8 + 4] + tb[0], o[q * 8 + 5] + tb[1], o[q * 8 + 6] + tb[2], o[q * 8 + 7] + tb[3]};
        *(u32x4*)(yb + (size_t)tok * D + c0 + q * 8) = pg8::pack8(ya, yb_);
        ss += (ya[0] * ya[0] + ya[1] * ya[1]) + (ya[2] * ya[2] + ya[3] * ya[3]) + (yb_[0] * yb_[0] + yb_[1] * yb_[1]) + (yb_[2] * yb_[2] + yb_[3] * yb_[3]); }
    ss += __shfl_xor(ss, 1); ss += __shfl_xor(ss, 2); ss += __shfl_xor(ss, 4);
    if (l8 == 0) ssq[(size_t)tok * 8 + x] = ss;
    asm volatile("s_waitcnt lgkmcnt(0)" ::: "memory");
}
DI void peer_norm_rows(Frame& F, const bf16_t* __restrict__ yb, float* __restrict__ out, const float* __restrict__ ssq, const float* __restrict__ gfin) {
    for (int row0 = F.gw * 2; row0 < M; row0 += F.NGW * 2) {
        u32x4 w[2][4]; float r[2];
#pragma unroll
        for (int i = 0; i < 2; ++i) { const int row = row0 + i;
#pragma unroll
            for (int j = 0; j < 4; ++j) w[i][j] = *(const u32x4*)(yb + (size_t)row * D + (F.lane + 64 * j) * 8);
            const f32x4 s0 = *(const f32x4*)(ssq + (size_t)row * 8), s1 = *(const f32x4*)(ssq + (size_t)row * 8 + 4);
            r[i] = rsqrtf(((s0[0] + s0[1]) + (s0[2] + s0[3]) + (s1[0] + s1[1]) + (s1[2] + s1[3])) * (1.f / D) + EPS); }
#pragma unroll
        for (int i = 0; i < 2; ++i)
#pragma unroll
            for (int j = 0; j < 4; ++j) { f32x4 a, b; pg8::up8(w[i][j], a, b);
                const f32x4 ga = *(const f32x4*)(gfin + (F.lane + 64 * j) * 8), gb = *(const f32x4*)(gfin + (F.lane + 64 * j) * 8 + 4);
                float* op = out + (size_t)(row0 + i) * D + (F.lane + 64 * j) * 8;
                *(f32x4*)op = a * ga * r[i]; *(f32x4*)(op + 4) = b * gb * r[i]; }
    }
}

template <class Sched> DI void build_rtab(Frame& F, const Sched& S, const float* part) {
    LAS float* rt = (LAS float*)(F.lds + SPARE_OFF);
    pg8::Unit u;
    for (int i = 0; i < 12 && S.next(i, u); ++i) {
        if (F.tid < 256) { const float4* pp = (const float4*)(part + (size_t)(u.pm * 256 + F.tid) * 32); float s = 0.f;
#pragma unroll
            for (int j = 0; j < 8; ++j) { const float4 v = pp[j]; s += (v.x + v.y) + (v.z + v.w); }
            rt[i * 256 + F.tid] = rsqrtf(s * (1.f / D) + EPS); }
    }
    __syncthreads();
}

constexpr int CW_BAR = 4096;
#define PH(k)
__global__ void __launch_bounds__(NTHR, 2) mega_fwd(Args args) {
    extern __shared__ __attribute__((aligned(16))) unsigned char lds_raw[];
    Frame F;
    F.lds = (LAS unsigned char*)lds_raw; F.ldsg = lds_raw;
    F.tid = threadIdx.x; F.lane = F.tid & 63; F.wave = __builtin_amdgcn_readfirstlane(F.tid >> 6);
    F.G = gridDim.x; { const int bx = blockIdx.x; F.vcu = (F.G % 8 == 0) ? (bx % 8) * (F.G / 8) + bx / 8 : bx; }
    F.gw = F.vcu * NWAVES + F.wave; F.NGW = F.G * NWAVES;
    volatile LAS unsigned* MISC = (volatile LAS unsigned*)(F.lds + MISC_OFF);
    if (F.tid < 64) MISC[F.tid] = 0u;
    __syncthreads();
    unsigned* ctl = (unsigned*)(args.ws + WS_CTL);
    XcdBarrier bar = xcd_barrier_post(ctl + CW_BAR, MISC + 8);
    const int c = (int)blockIdx.x, G = F.G;
    using pg8::SchedStd; using pg8::SchedOne; using pg8::Unit;

    PH(0) p0_prologue(F, args);
    xcd_barrier(bar);

    PH(1) {
        SchedStd S{(const char*)WB(WS_H1), (const char*)WB(WS_WINT), nullptr, nullptr, 2048, 2048, 64, 40, G, c, 1 << 20, 0, 0};
        pg8::EpiProj E{WB(WS_PROJA), WB(WS_PROJG)};
        pg8::gemm_phase<pg8::EpiProj, SchedStd, true>(F.lds, 2048, 2048, 2048, S, E);
    }
    PH(10) {
        SchedStd S{(const char*)WB(WS_MEMN), (const char*)WB(WS_WKVT), nullptr, nullptr, 2048, 2048, 4, 16, G, c, 1 << 20, 0, 0};
        pg8::EpiBf E{WB(WS_KVM), 4096};
        pg8::gemm_phase<pg8::EpiBf, SchedStd, true>(F.lds, 2048, 2048, 2048, S, E);
    }
    PH(11) {
        SchedOne S; S.have = (c >= 64 && c < 128); const int j = (c - 64) & 63, pmj = j >> 3, pn = j & 7;
        S.u0.pm = pmj; S.u0.pn = pn; S.u0.idx = 0; S.u0.s = 0;
        S.u0.a = (const char*)(WB(WS_AKEYS) + (size_t)pmj * 256 * 256); S.u0.b = (const char*)(WB(WS_WPQN) + (size_t)pn * 256 * 2048 + pmj * 256);
        pg8::EpiBf E{WB(WS_WPPT), 2048};
        pg8::gemm_phase<pg8::EpiBf, SchedOne, true>(F.lds, 256, 2048, 256, S, E);
    }
    if (c >= 64 && G > 64) convert_fp6_rows(F, args.in[19], args.ws + WS_EU, WF(WS_SCU), NEXP, (c - 64) * NWAVES + F.wave, (G - 64) * NWAVES, F.lds + F.wave * 17408);
    xcd_barrier(bar);

    PH(2) for (int i = 0; i < 2; ++i) { const int unit = F.vcu * 2 + i; if (unit < 512) battn_unit(F.lds, WB(WS_PROJA), args.in[6], WB(WS_OATT), unit); }
    PH(12) for (int gid = F.vcu * NTHR + F.tid; gid < (M / 16) * 128; gid += G * NTHR) conv_item(WB(WS_PROJA), args.in[4], args.in[5], WB(WS_YC), gid);
    PH(13) {
        SchedOne S; S.have = (c < 256); S.u0.idx = 0; S.u0.s = 0;
        const int j = c & 127, b = j >> 5, head = (j >> 3) & 3, t8 = j & 7;
        if (c < 128) {
            S.u0.pm = b * 4 + head; S.u0.pn = t8;
            S.u0.a = (const char*)(WB(WS_KVM) + (size_t)(b * 256) * 4096 + head * 512); S.u0.b = (const char*)(WB(WS_WCQN) + (size_t)(t8 * 256) * 2048 + head * 512);
            pg8::EpiBf E{WB(WS_WST), 2048};
            pg8::gemm_phase<pg8::EpiBf, SchedOne, true>(F.lds, 4096, 2048, 512, S, E);
        } else {
            S.u0.pm = b * 8 + t8; S.u0.pn = head;
            S.u0.a = (const char*)(WB(WS_WCOT) + (size_t)(t8 * 256) * 2048 + head * 512); S.u0.b = (const char*)(WB(WS_KVM) + (size_t)(b * 256) * 4096 + 2048 + head * 512);
            pg8::EpiBf E{WB(WS_WOT), 1024};
            pg8::gemm_phase<pg8::EpiBf, SchedOne, true>(F.lds, 2048, 4096, 512, S, E);
        }
    }
    xcd_barrier(bar);

    PH(3) {
        SchedStd S{(const char*)WB(WS_OATT), (const char*)WB(WS_WATT), (const char*)WB(WS_YC), (const char*)WB(WS_WCONV), 1024, 1024, 64, 8, G, c, 1 << 20, 1, 0};
        pg8::EpiMerge E{WB(WS_PROJG), WB(WS_SCR), WB(WS_MERGED)};
        pg8::gemm_phase<pg8::EpiMerge, SchedStd, true>(F.lds, 1024, 1024, 1024, S, E);
    }
    xcd_barrier(bar);

    PH(4) {
        SchedStd S{(const char*)WB(WS_MERGED), (const char*)WB(WS_WMIX), nullptr, nullptr, 2048, 2048, 64, 8, G, c, 1 << 20, 0, 0};
        pg8::EpiRes<false> E{args.in[0], WB(WS_X1BF), WF(WS_PART1)};
        pg8::gemm_phase<pg8::EpiRes<false>, SchedStd, true>(F.lds, 2048, 2048, 2048, S, E);
    }
    xcd_barrier(bar);

    PH(5) {
        SchedStd S{(const char*)WB(WS_X1BF), (const char*)WB(WS_WST), nullptr, nullptr, 2048, 2048, 64, 4, G, c, 16, 0, (size_t)1024 * 2048 * 2};
        build_rtab(F, S, WF(WS_PART1));
        pg8::EpiSoftmax E{WB(WS_PB), (const LAS float*)(F.lds + SPARE_OFF)};
        pg8::gemm_phase<pg8::EpiSoftmax, SchedStd, false>(F.lds, 2048, 2048, 2048, S, E);
    }
    xcd_barrier(bar);

    PH(6) {
        SchedStd S{(const char*)WB(WS_PB), (const char*)WB(WS_WOT), nullptr, nullptr, 1024, 1024, 64, 8, G, c, 16, 0, (size_t)2048 * 1024 * 2};
        pg8::EpiRes<true> E{WB(WS_X1BF), WB(WS_X2BF), WF(WS_PART2)};
        pg8::gemm_phase<pg8::EpiRes<true>, SchedStd, true>(F.lds, 1024, 1024, 1024, S, E);
    }
    xcd_barrier(bar);

    PH(7) {
        SchedStd S{(const char*)WB(WS_X2BF), (const char*)WB(WS_WPPT), nullptr, nullptr, 2048, 2048, 64, 8, G, c, 1 << 20, 0, 0};
        build_rtab(F, S, WF(WS_PART2));
        pg8::EpiScore E{WF(WS_SCORES), (const LAS float*)(F.lds + SPARE_OFF)};
        pg8::gemm_phase<pg8::EpiScore, SchedStd, true>(F.lds, 2048, 2048, 2048, S, E);
    }
    xcd_barrier(bar);

    PH(8) for (int it = F.gw; it < M / 4; it += F.NGW) topk_item4(WF(WS_SCORES), (int*)(args.ws + WS_IDX), WF(WS_GATE), it, F.lds + F.wave * 17408, F.lane);
    PH(14) { if (G <= 64) convert_fp6_rows(F, args.in[19], args.ws + WS_EU, WF(WS_SCU), NEXP, F.gw, F.NGW, F.lds + F.wave * 17408);
    convert_fp6_rows(F, args.in[20], args.ws + WS_EV, WF(WS_SCV), NEXP, F.gw, F.NGW, F.lds + F.wave * 17408); }
    xcd_barrier(bar);

    const int xv = c & 7, wx = (c >> 3) * NWAVES + F.wave, nwx = (G >> 3) * NWAVES;
    PH(9) for (int t0 = wx * 8; t0 < M; t0 += nwx * 8)
        peer_u_round(F.lds + F.wave * 8192, WB(WS_X2BF), WF(WS_PART2), args.in[16], (const int*)(args.ws + WS_IDX), args.ws + WS_EU, WF(WS_PD), t0, xv, F.lane);
    xcd_barrier(bar);
    PH(15) peer_act(F, WF(WS_PD), (const int*)(args.ws + WS_IDX), WF(WS_GATE), WF(WS_SCU), WF(WS_SCV), WF(WS_ACT));
    xcd_barrier(bar);
    PH(16) for (int t0 = wx * 8; t0 < M; t0 += nwx * 8)
        peer_v_round(F.lds + F.wave * 8192, WB(WS_X2BF), (const int*)(args.ws + WS_IDX), WF(WS_ACT), args.ws + WS_EV, WB(WS_YB), WF(WS_SSQ), t0, xv, F.lane);
    xcd_barrier(bar);
    PH(17) peer_norm_rows(F, WB(WS_YB), args.out, WF(WS_SSQ), args.in[21]);
}

extern "C" void kernel_launch(void* const* d_in, const int* in_sizes, int n_in, void* d_out, int out_size, void* d_ws, size_t ws_size, hipStream_t stream) {
    static int grid = 0;
    if (grid == 0) {
        if (n_in != 22 || ws_size < WS_END) { fprintf(stderr, "kernel_launch: unexpected n_in %d or ws_size %zu (< %zu)\n", n_in, ws_size, (size_t)WS_END); grid = -1; return; }
        int dev = 0, cus = 0, per_cu = 0;
        if (hipGetDevice(&dev) != hipSuccess || hipDeviceGetAttribute(&cus, hipDeviceAttributeMultiprocessorCount, dev) != hipSuccess) { grid = -1; return; }
        if (hipFuncSetAttribute((const void*)mega_fwd, hipFuncAttributeMaxDynamicSharedMemorySize, LDS_BYTES) != hipSuccess) { fprintf(stderr, "kernel_launch: hipFuncSetAttribute failed\n"); grid = -1; return; }
        if (hipOccupancyMaxActiveBlocksPerMultiprocessor(&per_cu, (const void*)mega_fwd, NTHR, LDS_BYTES) != hipSuccess || per_cu < 1) { fprintf(stderr, "kernel_launch: occupancy query says %d\n", per_cu); per_cu = 1; }
        (void)hipGetLastError();
        grid = cus;
        if (grid > 256) grid = 256;
    }
    if (grid < 0) return;
    (void)hipMemsetAsync((char*)d_ws + WS_CTL, 0, 65536, stream);
    Args a{};
    for (int i = 0; i < 22; ++i) a.in[i] = (const float*)d_in[i];
    a.out = (float*)d_out; a.ws = (unsigned char*)d_ws;
    void* kargs[] = {&a};
    hipError_t e = hipLaunchCooperativeKernel((const void*)mega_fwd, dim3(grid), dim3(NTHR), kargs, LDS_BYTES, stream);
    if (e != hipSuccess) fprintf(stderr, "kernel_launch: cooperative launch failed: %s (grid %d)\n", hipGetErrorString(e), grid);
}
```

```cpp
#include <hip/hip_runtime.h>
#include <cstdio>
#include <cstdint>

#define DI __device__ __forceinline__
#define LAS __attribute__((address_space(3)))
#define GAS __attribute__((address_space(1)))
typedef unsigned short bf16_t;
typedef short bf16x8 __attribute__((ext_vector_type(8)));
typedef float f32x4 __attribute__((ext_vector_type(4)));
typedef unsigned u32x4 __attribute__((ext_vector_type(4)));
typedef float f32x2v __attribute__((ext_vector_type(2)));

constexpr int D = 2048, NB = 4, SEQ = 4096, M = NB * SEQ;
constexpr int INC = 10240, PA = 6144, PG = 4096;
constexpr int MROWS = 1024;
constexpr int NEXP = 16384;
constexpr float EPS = 1e-6f;
constexpr int NWAVES = 8, NTHR = 512;

constexpr size_t MiB = 1u << 20;
constexpr size_t WS_CTL = 0;
constexpr size_t WS_WINT = 1 * MiB;
constexpr size_t WS_WKVT = 41 * MiB;
constexpr size_t WS_WATT = 57 * MiB;
constexpr size_t WS_WCONV = 61 * MiB;
constexpr size_t WS_WMIX = 65 * MiB;
constexpr size_t WS_WCOT = 73 * MiB;
constexpr size_t WS_WCQN = 81 * MiB;
constexpr size_t WS_WPPT = 89 * MiB;
constexpr size_t WS_WST = 97 * MiB;
constexpr size_t WS_WOT = 113 * MiB;
constexpr size_t WS_MEMN = 129 * MiB;
constexpr size_t WS_KVM = 133 * MiB;
constexpr size_t WS_H1 = 141 * MiB;
constexpr size_t WS_OATT = 141 * MiB;
constexpr size_t WS_YC = 173 * MiB;
constexpr size_t WS_X1BF = 141 * MiB;
constexpr size_t WS_X2BF = 141 * MiB;
constexpr size_t WS_EU = 535 * MiB;
constexpr size_t WS_EV = 559 * MiB;
constexpr size_t WS_SCU = 583 * MiB;
constexpr size_t WS_SCV = 583 * MiB + 65536;
constexpr size_t WS_SSQ = 21 * MiB + 131072;
constexpr size_t WS_ACT = 22 * MiB;
constexpr size_t WS_YB = 269 * MiB;
constexpr size_t WS_PD = 205 * MiB;
constexpr size_t WS_PROJA = 205 * MiB;
constexpr size_t WS_MERGED = 205 * MiB;
constexpr size_t WS_PB = 205 * MiB;
constexpr size_t WS_SCR = 269 * MiB;
constexpr size_t WS_X2F = 269 * MiB;
constexpr size_t WS_PROJG = 397 * MiB;
constexpr size_t WS_X1F = 397 * MiB;
constexpr size_t WS_SCORES = 397 * MiB;
constexpr size_t WS_AKEYS = 525 * MiB;
constexpr size_t WS_WPQN = 526 * MiB;
constexpr size_t WS_END = 584 * MiB;
constexpr size_t WS_PART1 = 1 * MiB;
constexpr size_t WS_PART2 = 3 * MiB;
constexpr size_t WS_IDX = 5 * MiB;
constexpr size_t WS_GATE = 13 * MiB;

constexpr int RING_BYTES = 131072;
constexpr int SPARE_OFF = RING_BYTES;
constexpr int MISC_OFF = RING_BYTES + 12288;
constexpr int LDS_BYTES = 147456;

DI float bf2f(unsigned v) { return __uint_as_float(v << 16); }
DI unsigned f2bf(float f) { unsigned u = __float_as_uint(f); return (u + 0x7fffu + ((u >> 16) & 1u)) >> 16; }
DI unsigned pk2(float lo, float hi) { unsigned r; asm("v_cvt_pk_bf16_f32 %0, %1, %2" : "=v"(r) : "v"(lo), "v"(hi)); return r; }
DI float wave_sum(float v) {
#pragma unroll
    for (int o = 1; o < 64; o <<= 1) v += __shfl_xor(v, o);
    return v;
}
DI float wave_max(float v) {
#pragma unroll
    for (int o = 1; o < 64; o <<= 1) v = fmaxf(v, __shfl_xor(v, o));
    return v;
}
DI void unpack8(const uint4 v, float* o) { o[0] = bf2f(v.x & 0xffffu); o[1] = bf2f(v.x >> 16); o[2] = bf2f(v.y & 0xffffu); o[3] = bf2f(v.y >> 16); o[4] = bf2f(v.z & 0xffffu); o[5] = bf2f(v.z >> 16); o[6] = bf2f(v.w & 0xffffu); o[7] = bf2f(v.w >> 16); }

#define XB_TMO      128
#define XB_XCNT(j)  (256  + 64 * (j))
#define XB_XSUB(j)  (1280 + 64 * (j))
#define XB_XGEN(j)  (2304 + 64 * (j))
#define XB_TOP      3328
#define XB_TOPGEN   3392
#define XCD_BAR_WORDS 3456
#define XB_SPIN_CAP (1u << 20)
DI unsigned xb_ld(unsigned* p)              { return __hip_atomic_load(p, __ATOMIC_RELAXED, __HIP_MEMORY_SCOPE_AGENT); }
DI unsigned xb_add(unsigned* p, unsigned v) { return __hip_atomic_fetch_add(p, v, __ATOMIC_RELAXED, __HIP_MEMORY_SCOPE_AGENT); }
DI unsigned xb_xcc_id() { return (unsigned)__builtin_amdgcn_s_getreg((3 << 11) | 20) & 0xFu; }
#define XB_SPIN(cond, bar) do { unsigned _sp = 0; while (cond) { __builtin_amdgcn_s_sleep(1); \
    if ((++_sp & 255u) == 0u) { if (xb_ld(&(bar)[XB_TMO])) break; if (_sp > XB_SPIN_CAP) { atomicAdd(&(bar)[XB_TMO], 1u); break; } } } } while (0)
struct XcdBarrier { unsigned* bar; unsigned x; volatile LAS unsigned* st; };
DI XcdBarrier xcd_barrier_post(unsigned* bar, volatile LAS unsigned* st) {
    XcdBarrier b; b.bar = bar; b.x = xb_xcc_id(); b.st = st;
    if (threadIdx.x == 0) (void)xb_add(&bar[XB_XCNT(b.x)], 1u);
    return b;
}
DI void xcd_barrier_complete(unsigned* bar, unsigned x, unsigned& nloc, unsigned& nx) {
    const unsigned G = gridDim.x;
    unsigned sum, cnt, mine, sp = 0u;
    for (;;) {
        sum = 0u; cnt = 0u; mine = 0u;
#pragma unroll
        for (unsigned j = 0; j < 16; ++j) { const unsigned c = xb_ld(&bar[XB_XCNT(j)]); sum += c; cnt += (c > 0u) ? 1u : 0u; mine = (j == x) ? c : mine; }
        if (sum == G) break;
        __builtin_amdgcn_s_sleep(1);
        if ((++sp & 255u) == 0u) { if (xb_ld(&bar[XB_TMO])) break; if (sp > XB_SPIN_CAP) { atomicAdd(&bar[XB_TMO], 1u); break; } }
    }
    nloc = mine > 0u ? mine : 1u; nx = cnt > 0u ? cnt : 1u;
}
DI void xcd_barrier(const XcdBarrier& b) {
    asm volatile("s_waitcnt vmcnt(0)" ::: "memory");
    __syncthreads();
    if (threadIdx.x == 0) {
        unsigned* bar = b.bar;
        __builtin_amdgcn_s_waitcnt(0);
        unsigned nloc = b.st[0], nx = b.st[1];
        if (nloc == 0u) { xcd_barrier_complete(bar, b.x, nloc, nx); b.st[0] = nloc; b.st[1] = nx; }
        const unsigned old = xb_add(&bar[XB_XSUB(b.x)], 1u);
        const unsigned gen = old / nloc;
        if (old + 1u == (gen + 1u) * nloc) {
            __builtin_amdgcn_fence(__ATOMIC_RELEASE, "agent");
            asm volatile("s_waitcnt vmcnt(0)" ::: "memory");
            const unsigned og = xb_add(&bar[XB_TOP], 1u);
            const unsigned tg = og / nx;
            if (og + 1u == (tg + 1u) * nx) xb_add(&bar[XB_TOPGEN], 1u);
            else XB_SPIN(xb_ld(&bar[XB_TOPGEN]) == tg, bar);
            __builtin_amdgcn_fence(__ATOMIC_ACQUIRE, "agent");
            xb_add(&bar[XB_XGEN(b.x)], 1u);
            asm volatile("s_waitcnt vmcnt(0)" ::: "memory");
        } else {
            XB_SPIN(xb_ld(&bar[XB_XGEN(b.x)]) == gen, bar);
            __builtin_amdgcn_fence(__ATOMIC_ACQUIRE, "agent");
            asm volatile("s_waitcnt vmcnt(0)" ::: "memory");
        }
    }
    __syncthreads();
}

namespace pg8 {
constexpr int BM = 256, BK = 64, HALF = 128, HTB = HALF * BK * 2, NXCD = 8, WGM = 2;
DI int lds_byte(int r, int c) { const int st = (r >> 4) * 2 + (c >> 5), rr = r & 15, cc = c & 31, ob = rr * 64 + cc * 2; return st * 1024 + (ob ^ (((ob >> 9) & 1) << 5)); }
DI void stage_rc(int b, int& R, int& C) { const int st = b / 1024, sb = b % 1024, swz = sb ^ (((sb >> 9) & 1) << 5); R = (st >> 1) * 16 + swz / 64; C = (st & 1) * 32 + (swz % 64) / 2; }
DI int perm32(int rho) { const int n = rho >> 4, i = rho & 15; return 8 * (i >> 2) + 4 * n + (i & 3); }
struct Unit { int pm, pn, idx, s; const char* a; const char* b; };
DI void tile_of(int L, int nM, int nN, int& pm, int& pn) {
    const int nwg = nM * nN; int wgid = L;
    { const int q = nwg / NXCD, r = nwg % NXCD, xcd = wgid % NXCD, off = wgid / NXCD; wgid = (xcd < r ? xcd * (q + 1) : r * (q + 1) + (xcd - r) * q) + off; }
    const int nig = WGM * nN, gid = wgid / nig, fm = gid * WGM, gsz = (nM - fm) < WGM ? (nM - fm) : WGM;
    pm = fm + ((wgid % nig) % gsz); pn = (wgid % nig) / gsz;
}
template <class Epi, class Sched, bool ALIGN_EPI>
DI void gemm_phase(LAS unsigned char* lds, const int lda, const int ldb, const int K, const Sched& S, const Epi& E) {
    int tid = threadIdx.x; asm volatile("" : "+v"(tid));
    const int wid = __builtin_amdgcn_readfirstlane(tid >> 6), lane = tid & 63, wr = wid >> 2, wc = wid & 3, fr = lane & 15, fq = lane >> 4;
    const int nt = K / BK;
    unsigned voffA[2], voffB[2];
#pragma unroll
    for (int i = 0; i < 2; ++i) { int R, C; stage_rc(tid * 16 + i * 8192, R, C); const int Rb = (R & ~31) + perm32(R & 31);
        voffA[i] = (unsigned)(R * lda + C) * 2u; voffB[i] = (unsigned)(Rb * ldb + C) * 2u; }
    const size_t kstep = (size_t)(BK * 2);
    const size_t hA = (size_t)HALF * lda * 2, hB = (size_t)HALF * ldb * 2;
    const unsigned ldsw = (unsigned)wid * 1024u;
    const int aoff = lds_byte(wr * 64 + fr, fq * 8), boff = lds_byte(wc * 32 + fr, fq * 8);
#define PG8_SA(b, h) (((b) * 2 + (h)) * HTB)
#define PG8_SB(b, h) ((4 + (b) * 2 + (h)) * HTB)
#define PG8_STAGE(bufoff, gbase, voff) do { _Pragma("unroll") for (int _i = 0; _i < 2; ++_i) \
        __builtin_amdgcn_global_load_lds((const unsigned*)((const char*)(gbase) + (voff)[_i]), (LAS unsigned*)(lds + (bufoff) + ldsw + _i * 8192), 16, 0, 0); } while (0)
#define PG8_LDA(dst, b, h) do { _Pragma("unroll") for (int m = 0; m < 4; ++m) _Pragma("unroll") for (int k = 0; k < 2; ++k) dst[m][k] = *(const LAS bf16x8*)(lds + PG8_SA(b, h) + aoff + m * 2048 + k * 1024); } while (0)
#define PG8_LDB(dst, b, h) do { _Pragma("unroll") for (int n = 0; n < 2; ++n) _Pragma("unroll") for (int k = 0; k < 2; ++k) dst[n][k] = *(const LAS bf16x8*)(lds + PG8_SB(b, h) + boff + n * 2048 + k * 1024); } while (0)
#define PG8_MMA(ai, bj, At, Bt) do { __builtin_amdgcn_s_setprio(1); _Pragma("unroll") for (int m = 0; m < 4; ++m) _Pragma("unroll") for (int n = 0; n < 2; ++n) _Pragma("unroll") for (int k = 0; k < 2; ++k) \
        acc[ai][bj][m][n] = __builtin_amdgcn_mfma_f32_16x16x32_bf16(Bt[n][k], At[m][k], acc[ai][bj][m][n], 0, 0, 0); __builtin_amdgcn_s_setprio(0); } while (0)
#define PG8_WAIT_V(n) asm volatile("s_waitcnt vmcnt(" #n ")" ::: "memory")
#define PG8_WAIT_L(n) asm volatile("s_waitcnt lgkmcnt(" #n ")" ::: "memory")
#define PG8_BAR __builtin_amdgcn_s_barrier()
#define PG8_SCHED __builtin_amdgcn_sched_barrier(0)
    Unit cur, nxt; int ui = 0;
    if (!S.next(0, cur)) return;
    f32x4 acc[2][2][4][2];
#pragma unroll
    for (int a = 0; a < 2; ++a)
#pragma unroll
        for (int b = 0; b < 2; ++b)
#pragma unroll
            for (int m = 0; m < 4; ++m)
#pragma unroll
                for (int n = 0; n < 2; ++n) acc[a][b][m][n] = (f32x4){0.f, 0.f, 0.f, 0.f};
    bf16x8 At[4][2], B0[2][2], B1[2][2];
    const char* cA = cur.a; const char* cB = cur.b;
    PG8_STAGE(PG8_SB(0, 0), cB, voffB); PG8_STAGE(PG8_SB(0, 1), cB + hB, voffB); PG8_STAGE(PG8_SA(0, 0), cA, voffA); PG8_STAGE(PG8_SA(0, 1), cA + hA, voffA);
    if (wr == 1) PG8_BAR;
    PG8_WAIT_V(2); PG8_BAR;
    PG8_STAGE(PG8_SB(1, 0), cB + kstep, voffB); PG8_STAGE(PG8_SA(1, 0), cA + kstep, voffA); PG8_STAGE(PG8_SB(1, 1), cB + hB + kstep, voffB);
    PG8_WAIT_V(6); PG8_BAR;
    for (;;) {
        const bool has_next = S.next(ui + 1, nxt);
        const char* nA = has_next ? nxt.a : cA; const char* nB = has_next ? nxt.b : cB;
        for (int t = 0; t < nt; t += 2) {
            const bool last = (t == nt - 2);
            const char* a1 = cA + (size_t)(t + 1) * kstep;
            const char* a2 = last ? nA : cA + (size_t)(t + 2) * kstep; const char* b2 = last ? nB : cB + (size_t)(t + 2) * kstep;
            const char* a3 = a2 + kstep; const char* b3 = b2 + kstep;
            PG8_LDB(B0, 0, 0); PG8_LDB(B1, 0, 1); PG8_SCHED; PG8_LDA(At, 0, 0); PG8_STAGE(PG8_SA(1, 1), a1 + hA, voffA);
            PG8_WAIT_V(8); PG8_WAIT_L(0); PG8_BAR; PG8_MMA(0, 0, At, B0); PG8_MMA(0, 1, At, B1); PG8_BAR; PG8_SCHED;
            PG8_LDA(At, 0, 1); PG8_STAGE(PG8_SB(0, 0), b2, voffB); PG8_STAGE(PG8_SB(0, 1), b2 + hB, voffB); PG8_STAGE(PG8_SA(0, 0), a2, voffA);
            PG8_WAIT_V(8); PG8_WAIT_L(0); PG8_BAR; PG8_MMA(1, 0, At, B0); PG8_MMA(1, 1, At, B1); PG8_BAR; PG8_SCHED;
            PG8_LDB(B0, 1, 0); PG8_LDB(B1, 1, 1); PG8_SCHED; PG8_LDA(At, 1, 0); PG8_STAGE(PG8_SA(0, 1), a2 + hA, voffA);
            PG8_WAIT_V(8); PG8_WAIT_L(0); PG8_BAR; PG8_MMA(0, 0, At, B0); PG8_MMA(0, 1, At, B1); PG8_BAR; PG8_SCHED;
            PG8_LDA(At, 1, 1); PG8_STAGE(PG8_SB(1, 0), b3, voffB); PG8_STAGE(PG8_SB(1, 1), b3 + hB, voffB); PG8_STAGE(PG8_SA(1, 0), a3, voffA);
            PG8_WAIT_V(8); PG8_WAIT_L(0); PG8_BAR; PG8_MMA(1, 0, At, B0); PG8_MMA(1, 1, At, B1); PG8_BAR; PG8_SCHED;
        }
        if constexpr (ALIGN_EPI) { if (wr == 0) PG8_BAR; }
        if constexpr (!Epi::AFTER_DRAIN) { E(acc, cur, wr, wc, fr, fq); }
        if (!has_next) break;
#pragma unroll
        for (int a = 0; a < 2; ++a)
#pragma unroll
            for (int b = 0; b < 2; ++b)
#pragma unroll
                for (int m = 0; m < 4; ++m)
#pragma unroll
                    for (int n = 0; n < 2; ++n) acc[a][b][m][n] = (f32x4){0.f, 0.f, 0.f, 0.f};
        cur = nxt; cA = nA; cB = nB; ++ui;
        if constexpr (ALIGN_EPI) { if (wr == 1) PG8_BAR; }
    }
    PG8_WAIT_V(0);
    if constexpr (!ALIGN_EPI) { if (wr == 0) PG8_BAR; }
    PG8_BAR;
    if constexpr (Epi::AFTER_DRAIN) { E.fused(acc, cur, wr, wc, fr, fq, lds, wid, lane); }
#undef PG8_SA
#undef PG8_SB
#undef PG8_STAGE
#undef PG8_LDA
#undef PG8_LDB
#undef PG8_MMA
#undef PG8_WAIT_V
#undef PG8_WAIT_L
#undef PG8_BAR
#undef PG8_SCHED
}

struct SchedStd {
    const char* A0; const char* B0; const char* A1; const char* B1; int lda, ldb, nM, nN, G, c, pm_per_batch, dual; size_t bstride;
    DI bool next(int i, Unit& u) const {
        const int ti = dual ? (i >> 1) : i; const long L = (long)ti * G + c; if (L >= (long)nM * nN) return false;
        { int pm_, pn_; tile_of((int)L, nM, nN, pm_, pn_); u.pm = __builtin_amdgcn_readfirstlane(pm_); u.pn = __builtin_amdgcn_readfirstlane(pn_); } u.idx = i; u.s = dual ? (i & 1) : 0;
        const char* A = u.s ? A1 : A0; const char* B = u.s ? B1 : B0;
        u.a = A + (size_t)u.pm * 256 * lda * 2; u.b = B + (size_t)u.pn * 256 * ldb * 2 + (size_t)(u.pm / pm_per_batch) * bstride;
        return true;
    }
};
struct SchedOne {
    int have; Unit u0;
    DI bool next(int i, Unit& u) const { if (i != 0 || !have) return false; u = u0; return true; }
};

DI unsigned cvt_pk_bf16(float lo, float hi) { unsigned r; asm volatile("v_cvt_pk_bf16_f32 %0, %1, %2" : "=v"(r) : "v"(lo), "v"(hi)); return r; }
DI u32x4 pack8(const f32x4 v0, const f32x4 v1) { u32x4 w; w.x = cvt_pk_bf16(v0[0], v0[1]); w.y = cvt_pk_bf16(v0[2], v0[3]); w.z = cvt_pk_bf16(v1[0], v1[1]); w.w = cvt_pk_bf16(v1[2], v1[3]); return w; }
DI float sig1(float v) { return __builtin_amdgcn_rcpf(1.f + __builtin_amdgcn_exp2f(v * -1.4426950408889634f)); }
DI f32x4 sig4(const f32x4 v) { f32x4 o; o[0] = sig1(v[0]); o[1] = sig1(v[1]); o[2] = sig1(v[2]); o[3] = sig1(v[3]); return o; }
DI void up8(const u32x4 w, f32x4& a, f32x4& b) { a[0] = bf2f(w.x & 0xffffu); a[1] = bf2f(w.x >> 16); a[2] = bf2f(w.y & 0xffffu); a[3] = bf2f(w.y >> 16); b[0] = bf2f(w.z & 0xffffu); b[1] = bf2f(w.z >> 16); b[2] = bf2f(w.w & 0xffffu); b[3] = bf2f(w.w >> 16); }
#define EPI_ROWS(...) _Pragma("unroll") for (int ai = 0; ai < 2; ++ai) _Pragma("unroll") for (int m = 0; m < 4; ++m) { const int lr = ai * 128 + wr * 64 + m * 16 + fr; const int row = u.pm * 256 + lr; (void)row; __VA_ARGS__ }
struct EpiBf { static constexpr bool AFTER_DRAIN = false; bf16_t* O; int ld;
    DI void operator()(const f32x4 (&acc)[2][2][4][2], const Unit& u, int wr, int wc, int fr, int fq) const { asm volatile("" : "+v"(fr), "+v"(fq));
        const int c0 = u.pn * 256 + wc * 32 + 8 * fq;
        EPI_ROWS( bf16_t* rp = O + (size_t)row * ld + c0;
            _Pragma("unroll") for (int bj = 0; bj < 2; ++bj) *(u32x4*)(rp + bj * 128) = pack8(acc[ai][bj][m][0], acc[ai][bj][m][1]); )
    } };
struct EpiProj { static constexpr bool AFTER_DRAIN = false; bf16_t* pa; bf16_t* pg;
    DI void operator()(const f32x4 (&acc)[2][2][4][2], const Unit& u, int wr, int wc, int fr, int fq) const { asm volatile("" : "+v"(fr), "+v"(fq));
        const int ct = u.pn * 256; const bool gate = ct >= PA;
        bf16_t* base = gate ? pg + (ct - PA) : pa + ct; const int ld = gate ? PG : PA; const int c0 = wc * 32 + 8 * fq;
        EPI_ROWS( bf16_t* rp = base + (size_t)row * ld + c0;
            _Pragma("unroll") for (int bj = 0; bj < 2; ++bj) { f32x4 v0 = acc[ai][bj][m][0], v1 = acc[ai][bj][m][1]; if (gate) { v0 = sig4(v0); v1 = sig4(v1); }
                *(u32x4*)(rp + bj * 128) = pack8(v0, v1); } )
    } };
struct EpiMerge { static constexpr bool AFTER_DRAIN = false; const bf16_t* pg; bf16_t* scr; bf16_t* mg;
    DI void operator()(const f32x4 (&acc)[2][2][4][2], const Unit& u, int wr, int wc, int fr, int fq) const { asm volatile("" : "+v"(fr), "+v"(fq));
        const int tid = (wr * 4 + wc) * 64 + fq * 16 + fr; bf16_t* my = scr + (size_t)blockIdx.x * 65536 + tid * 8;
        const int c0 = u.pn * 256 + wc * 32 + 8 * fq;
        if (u.s == 0) {
            EPI_ROWS( _Pragma("unroll") for (int bj = 0; bj < 2; ++bj)
                    *(u32x4*)(my + (size_t)((ai * 2 + bj) * 4 + m) * 4096) = pack8(acc[ai][bj][m][0], acc[ai][bj][m][1]); )
        } else {
            EPI_ROWS( _Pragma("unroll") for (int bj = 0; bj < 2; ++bj) {
                    const u32x4 ga = *(const u32x4*)(pg + (size_t)row * PG + c0 + bj * 128), gb = *(const u32x4*)(pg + (size_t)row * PG + 2048 + c0 + bj * 128);
                    const u32x4 tw = *(const u32x4*)(my + (size_t)((ai * 2 + bj) * 4 + m) * 4096);
                    f32x4 a0, a1, b0, b1, t0, t1; up8(ga, a0, a1); up8(gb, b0, b1); up8(tw, t0, t1);
                    *(u32x4*)(mg + (size_t)row * D + c0 + bj * 128) = pack8(a0 * t0 + b0 * acc[ai][bj][m][0], a1 * t1 + b1 * acc[ai][bj][m][1]);
                    asm volatile("" ::: "memory"); } )
        }
    } };
template <bool XI_BF16> struct EpiRes { static constexpr bool AFTER_DRAIN = false; const void* xi; bf16_t* xb; float* part;
    DI void operator()(const f32x4 (&acc)[2][2][4][2], const Unit& u, int wr, int wc, int fr, int fq) const { asm volatile("" : "+v"(fr), "+v"(fq));
        const int c0 = u.pn * 256 + wc * 32 + 8 * fq;
        EPI_ROWS( float ss = 0.f;
            _Pragma("unroll") for (int bj = 0; bj < 2; ++bj) { const size_t off = (size_t)row * D + c0 + bj * 128; f32x4 r0, r1;
                if constexpr (XI_BF16) { const u32x4 w = *(const u32x4*)((const bf16_t*)xi + off); up8(w, r0, r1); }
                else { r0 = *(const f32x4*)((const float*)xi + off); r1 = *(const f32x4*)((const float*)xi + off + 4); }
                const f32x4 v0 = acc[ai][bj][m][0] + r0, v1 = acc[ai][bj][m][1] + r1;
                *(u32x4*)(xb + off) = pack8(v0, v1);
                ss += (v0[0] * v0[0] + v0[1] * v0[1]) + (v0[2] * v0[2] + v0[3] * v0[3]) + (v1[0] * v1[0] + v1[1] * v1[1]) + (v1[2] * v1[2] + v1[3] * v1[3]); }
            ss += __shfl_xor(ss, 16); ss += __shfl_xor(ss, 32);
            if (fq == 0) part[(size_t)row * 32 + u.pn * 4 + wc] = ss;
            asm volatile("" ::: "memory"); )
    } };
struct EpiScore { static constexpr bool AFTER_DRAIN = false; float* S; const LAS float* rtab;
    DI void operator()(const f32x4 (&acc)[2][2][4][2], const Unit& u, int wr, int wc, int fr, int fq) const { asm volatile("" : "+v"(fr), "+v"(fq));
        const int c0 = u.pn * 256 + wc * 32 + 8 * fq;
        EPI_ROWS( const float r = rtab[u.idx * 256 + lr];
            _Pragma("unroll") for (int bj = 0; bj < 2; ++bj) { float* sp = S + (size_t)row * D + c0 + bj * 128;
                *(f32x4*)sp = acc[ai][bj][m][0] * r; *(f32x4*)(sp + 4) = acc[ai][bj][m][1] * r; } )
    } };
struct EpiSoftmax { static constexpr bool AFTER_DRAIN = true; bf16_t* P; const LAS float* rtab;
    DI void fused(f32x4 (&acc)[2][2][4][2], const Unit& u, int wr, int wc, int fr, int fq, LAS unsigned char* lds, int wid, int lane) const { asm volatile("" : "+v"(fr), "+v"(fq));
        LAS f32x2v* X = (LAS f32x2v*)lds;
        const float sc = 0.044194173824159216f * 1.4426950408889634f;
        EPI_ROWS( const float rs = rtab[lr] * sc; float mx = -3.0e38f;
            _Pragma("unroll") for (int bj = 0; bj < 2; ++bj) _Pragma("unroll") for (int n = 0; n < 2; ++n) { f32x4 v = acc[ai][bj][m][n] * rs; acc[ai][bj][m][n] = v; mx = fmaxf(mx, fmaxf(fmaxf(v[0], v[1]), fmaxf(v[2], v[3]))); }
            mx = fmaxf(mx, __shfl_xor(mx, 16)); mx = fmaxf(mx, __shfl_xor(mx, 32)); float sum = 0.f;
            _Pragma("unroll") for (int bj = 0; bj < 2; ++bj) _Pragma("unroll") for (int n = 0; n < 2; ++n) { f32x4 v = acc[ai][bj][m][n];
                v[0] = __builtin_amdgcn_exp2f(v[0] - mx); v[1] = __builtin_amdgcn_exp2f(v[1] - mx); v[2] = __builtin_amdgcn_exp2f(v[2] - mx); v[3] = __builtin_amdgcn_exp2f(v[3] - mx);
                acc[ai][bj][m][n] = v; sum += (v[0] + v[1]) + (v[2] + v[3]); }
            sum += __shfl_xor(sum, 16); sum += __shfl_xor(sum, 32);
            if (fq == 0) X[lr * 4 + wc] = (f32x2v){mx, sum}; )
        asm volatile("s_waitcnt lgkmcnt(0)" ::: "memory"); __builtin_amdgcn_s_barrier(); asm volatile("" ::: "memory");
        const int c0 = u.pn * 256 + wc * 32 + 8 * fq;
        EPI_ROWS( const f32x2v a = X[lr * 4 + 0], b = X[lr * 4 + 1], c = X[lr * 4 + 2], d = X[lr * 4 + 3];
            const float mt = fmaxf(fmaxf(a.x, b.x), fmaxf(c.x, d.x));
            const float lt = a.y * __builtin_amdgcn_exp2f(a.x - mt) + b.y * __builtin_amdgcn_exp2f(b.x - mt) + c.y * __builtin_amdgcn_exp2f(c.x - mt) + d.y * __builtin_amdgcn_exp2f(d.x - mt);
            const float own = (wc == 0) ? a.x : (wc == 1) ? b.x : (wc == 2) ? c.x : d.x;
            const float f = __builtin_amdgcn_exp2f(own - mt) * __builtin_amdgcn_rcpf(lt);
            bf16_t* rp = P + (size_t)row * 1024 + c0;
            _Pragma("unroll") for (int bj = 0; bj < 2; ++bj) *(u32x4*)(rp + bj * 128) = pack8(acc[ai][bj][m][0] * f, acc[ai][bj][m][1] * f); )
        asm volatile("s_waitcnt lgkmcnt(0)" ::: "memory"); __builtin_amdgcn_s_barrier();
    } };
}

struct Frame {
    LAS unsigned char* lds; unsigned char* ldsg;
    int tid, lane, wave, vcu, G, gw, NGW;
};
struct Args { const float* in[22]; float* out; unsigned char* ws; };
#define WB(off) ((bf16_t*)(args.ws + (off)))
#define WF(off) ((float*)(args.ws + (off)))

DI void p0_transpose_item(const float* W, int K, int N, bf16_t* WT, int row_off, float* scr, int item, int lane) {
    const int nblk = N / 32, kb = item / nblk, nb = item % nblk, k0 = 64 * kb, n0 = 32 * nb;
#pragma unroll 8
    for (int i = 0; i < 32; ++i) { const int kk = 2 * i + (lane >> 5); scr[kk * 33 + (lane & 31)] = W[(size_t)(k0 + kk) * N + n0 + (lane & 31)]; }
    asm volatile("s_waitcnt lgkmcnt(0)" ::: "memory");
    const int c = lane & 7;
#pragma unroll
    for (int j = 0; j < 4; ++j) { const int n = (lane >> 3) + 8 * j; const float* s = scr + (8 * c) * 33 + n;
        uint4 o; o.x = pk2(s[0 * 33], s[1 * 33]); o.y = pk2(s[2 * 33], s[3 * 33]); o.z = pk2(s[4 * 33], s[5 * 33]); o.w = pk2(s[6 * 33], s[7 * 33]);
        *(uint4*)(WT + (size_t)(row_off + n0 + n) * K + k0 + 8 * c) = o; }
    asm volatile("s_waitcnt lgkmcnt(0)" ::: "memory");
}
DI void convert_rows(Frame& F, const float* W, const float* g, bf16_t* O, int rows, int cols) {
    const size_t n8 = (size_t)rows * cols / 8;
    for (size_t i = (size_t)F.vcu * NTHR + F.tid; i < n8; i += (size_t)F.G * NTHR) {
        const size_t e = i * 8; const float s = g ? g[(int)(e / cols)] : 1.f;
        const float4 a = *(const float4*)(W + e), b = *(const float4*)(W + e + 4);
        uint4 o; o.x = pk2(a.x * s, a.y * s); o.y = pk2(a.z * s, a.w * s); o.z = pk2(b.x * s, b.y * s); o.w = pk2(b.z * s, b.w * s);
        *(uint4*)(O + e) = o;
    }
}
DI void rmsnorm_rows(Frame& F, const float* X, const float* g, bf16_t* O, int rows) {
    for (int row = F.gw; row < rows; row += F.NGW) {
        const float4* xr = (const float4*)(X + (size_t)row * D) + F.lane;
        float4 v[8]; float s = 0.f;
#pragma unroll
        for (int j = 0; j < 8; ++j) { v[j] = xr[64 * j]; s += v[j].x * v[j].x + v[j].y * v[j].y + v[j].z * v[j].z + v[j].w * v[j].w; }
        const float r = rsqrtf(wave_sum(s) * (1.f / D) + EPS);
        uint2* o = (uint2*)(O + (size_t)row * D) + F.lane;
#pragma unroll
        for (int j = 0; j < 8; ++j) { const float4 gg = ((const float4*)g)[F.lane + 64 * j];
            uint2 w; w.x = pk2(v[j].x * r * gg.x, v[j].y * r * gg.y); w.y = pk2(v[j].z * r * gg.z, v[j].w * r * gg.w); o[64 * j] = w; }
    }
}
DI void p0_prologue(Frame& F, const Args& args) {
    float* scr = (float*)(F.ldsg + F.wave * 16384);
    constexpr int I_IN = 32 * 320, I_AT = 16 * 64, I_SQ = 32 * 64;
    constexpr int NITEMS = I_IN + 2 * I_AT + 4 * I_SQ;
    for (int it = F.gw; it < NITEMS; it += F.NGW) {
        int r = it;
        if (r < I_IN) { p0_transpose_item(args.in[3], 2048, INC, WB(WS_WINT), 0, scr, r, F.lane); continue; } r -= I_IN;
        if (r < I_AT) { p0_transpose_item(args.in[7], 1024, 2048, WB(WS_WATT), 0, scr, r, F.lane); continue; } r -= I_AT;
        if (r < I_AT) { p0_transpose_item(args.in[8], 1024, 2048, WB(WS_WCONV), 0, scr, r, F.lane); continue; } r -= I_AT;
        if (r < I_SQ) { p0_transpose_item(args.in[9], 2048, 2048, WB(WS_WMIX), 0, scr, r, F.lane); continue; } r -= I_SQ;
        if (r < I_SQ) { p0_transpose_item(args.in[13], 2048, 2048, WB(WS_WKVT), 0, scr, r, F.lane); continue; } r -= I_SQ;
        if (r < I_SQ) { p0_transpose_item(args.in[14], 2048, 2048, WB(WS_WKVT), 2048, scr, r, F.lane); continue; } r -= I_SQ;
        p0_transpose_item(args.in[15], 2048, 2048, WB(WS_WCOT), 0, scr, r, F.lane);
    }
    convert_rows(F, args.in[12], args.in[10], WB(WS_WCQN), 2048, 2048);
    convert_rows(F, args.in[17], args.in[16], WB(WS_WPQN), 2048, 2048);
    for (int i = F.vcu * NTHR + F.tid; i < 2048 * 32; i += F.G * NTHR) {
        const int r = i >> 5, c8 = (i & 31) * 8, g = r >> 7; uint4 o = make_uint4(0u, 0u, 0u, 0u);
        if ((c8 >> 7) == (g & 1)) { const float* sp = args.in[18] + (size_t)r * 128 + (c8 & 127); const float4 a = *(const float4*)sp, b = *(const float4*)(sp + 4);
            o.x = pk2(a.x, a.y); o.y = pk2(a.z, a.w); o.z = pk2(b.x, b.y); o.w = pk2(b.z, b.w); }
        *(uint4*)(WB(WS_AKEYS) + (size_t)r * 256 + c8) = o;
    }
    rmsnorm_rows(F, args.in[0], args.in[2], WB(WS_H1), M);
    rmsnorm_rows(F, args.in[1], args.in[11], WB(WS_MEMN), MROWS);
}

typedef float f32x16 __attribute__((ext_vector_type(16)));
typedef short v4i16_t __attribute__((ext_vector_type(4)));
constexpr int BA_KROW = 272, BA_VROW = 320, BA_KSZ = 64 * BA_KROW, BA_BUF = BA_KSZ + 64 * BA_VROW, BA_TAB = 2 * BA_BUF;
DI int crow(int r, int hi) { return (r & 3) + 8 * (r >> 2) + 4 * hi; }
DI unsigned cvtpk(float lo, float hi) { unsigned r; asm volatile("v_cvt_pk_bf16_f32 %0, %1, %2" : "=v"(r) : "v"(lo), "v"(hi)); return r; }
DI bf16x8 pack_frag(const f32x16& p, int b) { u32x4 w; w.x = cvtpk(p[b], p[b + 1]); w.y = cvtpk(p[b + 2], p[b + 3]); w.z = cvtpk(p[b + 4], p[b + 5]); w.w = cvtpk(p[b + 6], p[b + 7]); return __builtin_bit_cast(bf16x8, w); }
DI void battn_unit(LAS unsigned char* lds, const bf16_t* __restrict__ pa, const float* __restrict__ relb, bf16_t* __restrict__ oatt, int unit) {
    int tid = threadIdx.x; asm volatile("" : "+v"(tid)); const int lane = tid & 63, wave = __builtin_amdgcn_readfirstlane(tid >> 6);
    const int cg = unit & 15, h = (unit >> 4) & 7, b = unit >> 7;
    const int c = cg * 4 + (wave >> 1), r32 = lane & 31, hi = lane >> 5, a = 32 * (wave & 1) + r32;
    const int tok = b * SEQ + c * 64 + a;
    const float LOG2E = 1.4426950408889634f, SC = 0.08838834764831845f * LOG2E;
    LAS float* tab = (LAS float*)(lds + BA_TAB);
    for (int i = tid; i < 257; i += NTHR) tab[i] = relb[h * 257 + i] * LOG2E;
    bf16x8 qf[8];
    { const bf16_t* qp = pa + (size_t)tok * PA + h * 128 + 8 * hi;
#pragma unroll
      for (int ks = 0; ks < 8; ++ks) qf[ks] = *(const bf16x8*)(qp + ks * 16); }
    f32x16 o0 = {}, o1 = {}, o2 = {}, o3 = {};
    float m = -1.0e30f, l = 0.f;
    const int src0 = cg * 4 - 8, first = src0 < 0 ? -src0 : 0;
    u32x4 kr0, kr1, vr0, vr1;
    const int key0 = tid >> 4, part = tid & 15;
    const bf16_t* gbase = pa + (size_t)(b * SEQ + key0) * PA + h * 128 + part * 8;
#define BA_GLOAD(src) do { const bf16_t* rp_ = gbase + (size_t)(src) * 64 * PA; kr0 = *(const u32x4*)(rp_ + 1024); vr0 = *(const u32x4*)(rp_ + 2048); \
        kr1 = *(const u32x4*)(rp_ + (size_t)32 * PA + 1024); vr1 = *(const u32x4*)(rp_ + (size_t)32 * PA + 2048); } while (0)
    BA_GLOAD(src0 + first);
    int buf = 0;
    const int vlane = (4 * hi + ((lane & 15) >> 2)) * BA_VROW + (16 * ((lane >> 4) & 1) + 4 * (lane & 3)) * 2;
    for (int kt = first; kt < 12; ++kt) {
        const int src = src0 + kt;
        LAS unsigned char* Kb = lds + buf * BA_BUF; LAS unsigned char* Vb = Kb + BA_KSZ;
        *(LAS u32x4*)(Kb + key0 * BA_KROW + part * 16) = kr0; *(LAS u32x4*)(Kb + (key0 + 32) * BA_KROW + part * 16) = kr1;
        *(LAS u32x4*)(Vb + key0 * BA_VROW + part * 16) = vr0; *(LAS u32x4*)(Vb + (key0 + 32) * BA_VROW + part * 16) = vr1;
        if (kt + 1 < 12) BA_GLOAD(src + 1);
        __syncthreads();
        const int dc = c - src;
        if (dc >= 0 && dc <= 8) {
            f32x16 p0 = {}, p1 = {};
            const LAS unsigned char* kp = Kb + r32 * BA_KROW + hi * 16;
#pragma unroll
            for (int ks = 0; ks < 8; ++ks) {
                const bf16x8 k0 = *(const LAS bf16x8*)(kp + ks * 32), k1 = *(const LAS bf16x8*)(kp + 32 * BA_KROW + ks * 32);
                p0 = __builtin_amdgcn_mfma_f32_32x32x16_bf16(k0, qf[ks], p0, 0, 0, 0);
                p1 = __builtin_amdgcn_mfma_f32_32x32x16_bf16(k1, qf[ks], p1, 0, 0, 0);
            }
            if (dc >= 3) { const float bc = tab[256];
#pragma unroll
                for (int r = 0; r < 16; ++r) { p0[r] = p0[r] * SC + bc; p1[r] = p1[r] * SC + bc; }
            } else { const int rb = dc * 64 + a + 128;
#pragma unroll
                for (int r = 0; r < 16; ++r) { const int i0 = rb - crow(r, hi), i1 = i0 - 32;
                    p0[r] = p0[r] * SC + tab[i0 > 256 ? 256 : i0]; p1[r] = p1[r] * SC + tab[i1 > 256 ? 256 : i1]; }
            }
            float mx = fmaxf(p0[0], p1[0]);
#pragma unroll
            for (int r = 1; r < 16; ++r) mx = fmaxf(mx, fmaxf(p0[r], p1[r]));
            mx = fmaxf(mx, __shfl_xor(mx, 32));
            const float mn = fmaxf(m, mx), alpha = __builtin_amdgcn_exp2f(m - mn); m = mn;
            float ls = 0.f;
#pragma unroll
            for (int r = 0; r < 16; ++r) { p0[r] = __builtin_amdgcn_exp2f(p0[r] - mn); p1[r] = __builtin_amdgcn_exp2f(p1[r] - mn); ls += p0[r] + p1[r]; }
            l = l * alpha + ls;
            o0 *= alpha; o1 *= alpha; o2 *= alpha; o3 *= alpha;
            bf16x8 pf[4]; pf[0] = pack_frag(p0, 0); pf[1] = pack_frag(p0, 8); pf[2] = pack_frag(p1, 0); pf[3] = pack_frag(p1, 8);
            const LAS unsigned char* vl = Vb + vlane;
#pragma unroll
            for (int s4 = 0; s4 < 4; ++s4) {
#define BA_VF(db) ({ const v4i16_t lo_ = __builtin_amdgcn_ds_read_tr16_b64_v4i16((LAS v4i16_t*)(vl + s4 * 16 * BA_VROW + (db) * 64)); \
                     const v4i16_t hi_ = __builtin_amdgcn_ds_read_tr16_b64_v4i16((LAS v4i16_t*)(vl + s4 * 16 * BA_VROW + 8 * BA_VROW + (db) * 64)); \
                     (bf16x8){lo_[0], lo_[1], lo_[2], lo_[3], hi_[0], hi_[1], hi_[2], hi_[3]}; })
                o0 = __builtin_amdgcn_mfma_f32_32x32x16_bf16(BA_VF(0), pf[s4], o0, 0, 0, 0);
                o1 = __builtin_amdgcn_mfma_f32_32x32x16_bf16(BA_VF(1), pf[s4], o1, 0, 0, 0);
                o2 = __builtin_amdgcn_mfma_f32_32x32x16_bf16(BA_VF(2), pf[s4], o2, 0, 0, 0);
                o3 = __builtin_amdgcn_mfma_f32_32x32x16_bf16(BA_VF(3), pf[s4], o3, 0, 0, 0);
#undef BA_VF
            }
        }
        buf ^= 1;
    }
#undef BA_GLOAD
    const float inv = __builtin_amdgcn_rcpf(l + __shfl_xor(l, 32));
    bf16_t* op = oatt + (size_t)tok * 1024 + h * 128 + 4 * hi;
#define BA_ST(o, db) do { _Pragma("unroll") for (int rg = 0; rg < 4; ++rg) { uint2 w_; w_.x = cvtpk(o[4 * rg] * inv, o[4 * rg + 1] * inv); w_.y = cvtpk(o[4 * rg + 2] * inv, o[4 * rg + 3] * inv); \
        *(uint2*)(op + (db) * 32 + 8 * rg) = w_; } } while (0)
    BA_ST(o0, 0); BA_ST(o1, 1); BA_ST(o2, 2); BA_ST(o3, 3);
#undef BA_ST
    __syncthreads();
}
DI void ld8bf(const bf16_t* p, float* o) { unpack8(*(const uint4*)p, o); }
DI void conv_item(const bf16_t* __restrict__ pa, const float* __restrict__ cw, const float* __restrict__ cb, bf16_t* __restrict__ yc, int gid) {
    const int cg = gid & 127, tb = gid >> 7, c0 = cg * 8, t0 = tb * 16;
    float w0[8], w1[8], w2[8], bb[8], m1[8], m2[8];
#pragma unroll
    for (int j = 0; j < 8; ++j) { w0[j] = cw[c0 + j]; w1[j] = cw[1024 + c0 + j]; w2[j] = cw[2048 + c0 + j]; bb[j] = cb[c0 + j]; m1[j] = 0.f; m2[j] = 0.f; }
    if ((t0 & (SEQ - 1)) != 0) {
        float u[8], c[8];
        ld8bf(pa + (size_t)(t0 - 2) * PA + 3072 + c0, u); ld8bf(pa + (size_t)(t0 - 2) * PA + 5120 + c0, c);
#pragma unroll
        for (int j = 0; j < 8; ++j) m2[j] = u[j] * c[j];
        ld8bf(pa + (size_t)(t0 - 1) * PA + 3072 + c0, u); ld8bf(pa + (size_t)(t0 - 1) * PA + 5120 + c0, c);
#pragma unroll
        for (int j = 0; j < 8; ++j) m1[j] = u[j] * c[j];
    }
    for (int t = t0; t < t0 + 16; ++t) {
        float u[8], c[8], g[8], y[8];
        ld8bf(pa + (size_t)t * PA + 3072 + c0, u); ld8bf(pa + (size_t)t * PA + 5120 + c0, c); ld8bf(pa + (size_t)t * PA + 4096 + c0, g);
#pragma unroll
        for (int j = 0; j < 8; ++j) { const float cu = u[j] * c[j]; y[j] = g[j] * (bb[j] + w0[j] * m2[j] + w1[j] * m1[j] + w2[j] * cu); m2[j] = m1[j]; m1[j] = cu; }
        uint4 o; o.x = pk2(y[0], y[1]); o.y = pk2(y[2], y[3]); o.z = pk2(y[4], y[5]); o.w = pk2(y[6], y[7]);
        *(uint4*)(yc + (size_t)t * 1024 + c0) = o;
    }
}

DI unsigned f2key(float f) { const unsigned u = __float_as_uint(f); return u ^ ((unsigned)((int)u >> 31) | 0x80000000u); }
DI float key2f(unsigned s) { return __uint_as_float(s ^ ((unsigned)((int)(~s) >> 31) | 0x80000000u)); }
#define INS16(T, key) do { unsigned v_ = (key); _Pragma("unroll") for (int q_ = 0; q_ < 16; ++q_) { const unsigned t_ = T[q_] > v_ ? T[q_] : v_; v_ = T[q_] > v_ ? v_ : T[q_]; T[q_] = t_; } } while (0)
#define CE_(x, y) do { const unsigned hi_ = (x) > (y) ? (x) : (y), lo_ = (x) > (y) ? (y) : (x); (x) = hi_; (y) = lo_; } while (0)
#define BSORT16(A) do { CE_(A[0], A[1]); CE_(A[3], A[2]); CE_(A[4], A[5]); CE_(A[7], A[6]); CE_(A[8], A[9]); CE_(A[11], A[10]); CE_(A[12], A[13]); CE_(A[15], A[14]); CE_(A[0], A[2]); CE_(A[1], A[3]); CE_(A[6], A[4]); CE_(A[7], A[5]); CE_(A[8], A[10]); CE_(A[9], A[11]); CE_(A[14], A[12]); CE_(A[15], A[13]); CE_(A[0], A[1]); CE_(A[2], A[3]); CE_(A[5], A[4]); CE_(A[7], A[6]); CE_(A[8], A[9]); CE_(A[10], A[11]); CE_(A[13], A[12]); CE_(A[15], A[14]); CE_(A[0], A[4]); CE_(A[1], A[5]); CE_(A[2], A[6]); CE_(A[3], A[7]); CE_(A[12], A[8]); CE_(A[13], A[9]); CE_(A[14], A[10]); CE_(A[15], A[11]); CE_(A[0], A[2]); CE_(A[1], A[3]); CE_(A[4], A[6]); CE_(A[5], A[7]); CE_(A[10], A[8]); CE_(A[11], A[9]); CE_(A[14], A[12]); CE_(A[15], A[13]); CE_(A[0], A[1]); CE_(A[2], A[3]); CE_(A[4], A[5]); CE_(A[6], A[7]); CE_(A[9], A[8]); CE_(A[11], A[10]); CE_(A[13], A[12]); CE_(A[15], A[14]); CE_(A[0], A[8]); CE_(A[1], A[9]); CE_(A[2], A[10]); CE_(A[3], A[11]); CE_(A[4], A[12]); CE_(A[5], A[13]); CE_(A[6], A[14]); CE_(A[7], A[15]); CE_(A[0], A[4]); CE_(A[1], A[5]); CE_(A[2], A[6]); CE_(A[3], A[7]); CE_(A[8], A[12]); CE_(A[9], A[13]); CE_(A[10], A[14]); CE_(A[11], A[15]); CE_(A[0], A[2]); CE_(A[1], A[3]); CE_(A[4], A[6]); CE_(A[5], A[7]); CE_(A[8], A[10]); CE_(A[9], A[11]); CE_(A[12], A[14]); CE_(A[13], A[15]); CE_(A[0], A[1]); CE_(A[2], A[3]); CE_(A[4], A[5]); CE_(A[6], A[7]); CE_(A[8], A[9]); CE_(A[10], A[11]); CE_(A[12], A[13]); CE_(A[14], A[15]); } while (0)
#define BMERGE16(A) do { CE_(A[0], A[8]); CE_(A[1], A[9]); CE_(A[2], A[10]); CE_(A[3], A[11]); CE_(A[4], A[12]); CE_(A[5], A[13]); CE_(A[6], A[14]); CE_(A[7], A[15]); CE_(A[0], A[4]); CE_(A[1], A[5]); CE_(A[2], A[6]); CE_(A[3], A[7]); CE_(A[8], A[12]); CE_(A[9], A[13]); CE_(A[10], A[14]); CE_(A[11], A[15]); CE_(A[0], A[2]); CE_(A[1], A[3]); CE_(A[4], A[6]); CE_(A[5], A[7]); CE_(A[8], A[10]); CE_(A[9], A[11]); CE_(A[12], A[14]); CE_(A[13], A[15]); CE_(A[0], A[1]); CE_(A[2], A[3]); CE_(A[4], A[5]); CE_(A[6], A[7]); CE_(A[8], A[9]); CE_(A[10], A[11]); CE_(A[12], A[13]); CE_(A[14], A[15]); } while (0)
#define TOPMERGE16(T, B) do { _Pragma("unroll") for (int q_ = 0; q_ < 16; ++q_) T[q_] = T[q_] > B[15 - q_] ? T[q_] : B[15 - q_]; BMERGE16(T); } while (0)
DI void topk_item4(const float* __restrict__ scores, int* __restrict__ idx, float* __restrict__ gate, int item, LAS unsigned char* wl, int lane) {
    const float* sp = scores + (size_t)item * 4 * D;
    unsigned top[16];
#pragma unroll 1
    for (int h = 0; h < 2; ++h) {
#pragma unroll
        for (int i = 0; i < 16; ++i) { const int grp = i * 4 + (lane >> 4), piece = lane & 15;
            const f32x4 v = *(const f32x4*)(sp + grp * 128 + h * 64 + piece * 4);
            *(LAS f32x4*)(wl + grp * 272 + piece * 16) = v; }
        asm volatile("s_waitcnt vmcnt(0) lgkmcnt(0)" ::: "memory");
#pragma unroll
        for (int bk = 0; bk < 4; ++bk) {
            unsigned blk[16];
#pragma unroll
            for (int j = 0; j < 4; ++j) { const f32x4 v = *(const LAS f32x4*)(wl + lane * 272 + (bk * 4 + j) * 16);
#pragma unroll
                for (int e = 0; e < 4; ++e) blk[j * 4 + e] = (f2key(v[e]) & ~127u) | (unsigned)(h * 64 + bk * 16 + j * 4 + e); }
            BSORT16(blk);
            if (h == 0 && bk == 0) {
#pragma unroll
                for (int q = 0; q < 16; ++q) top[q] = blk[q];
            } else TOPMERGE16(top, blk);
        }
        asm volatile("s_waitcnt lgkmcnt(0)" ::: "memory");
    }
    const int p = lane & 1;
    unsigned L1[16], L2[16]; float v1[16], v2[16];
#pragma unroll
    for (int i = 0; i < 16; ++i) { const unsigned pt = __shfl_xor(top[i], 1); L1[i] = p ? pt : top[i]; L2[i] = p ? top[i] : pt; v1[i] = key2f(L1[i] & ~127u); v2[i] = key2f(L2[i] & ~127u); }
    unsigned cd[64];
    { int n = 0;
#pragma unroll
      for (int i = 0; i < 16; ++i)
#pragma unroll
        for (int j = 0; j < 16; ++j) if ((i + 1) * (j + 1) <= 16) { cd[n] = (f2key(v1[i] + v2[j]) & ~255u) | (unsigned)(i * 16 + j); ++n; }
#pragma unroll
      for (int q = 50; q < 64; ++q) cd[q] = 0u; }
    unsigned ct[16];
#pragma unroll
    for (int bk = 0; bk < 4; ++bk) { unsigned blk[16];
#pragma unroll
        for (int q = 0; q < 16; ++q) blk[q] = cd[bk * 16 + q];
        BSORT16(blk);
        if (bk == 0) {
#pragma unroll
            for (int q = 0; q < 16; ++q) ct[q] = blk[q];
        } else TOPMERGE16(ct, blk); }
    const float mx = key2f(ct[0] & ~255u); float sum = 0.f;
#pragma unroll
    for (int t = 0; t < 16; ++t) sum += __expf(key2f(ct[t] & ~255u) - mx);
    const float isum = __builtin_amdgcn_rcpf(sum);
    const int tl = lane >> 4, head = (lane & 15) >> 1;
    const size_t ob = (size_t)(item * 4 + tl) * 128 + head * 16 + p * 8;
    { u32x4 w1, w2;
#define PK4(L, b) ((L[b] & 127u) | ((L[b + 1] & 127u) << 8) | ((L[b + 2] & 127u) << 16) | ((L[b + 3] & 127u) << 24))
      w1.x = PK4(L1, 0); w1.y = PK4(L1, 4); w1.z = PK4(L1, 8); w1.w = PK4(L1, 12); w2.x = PK4(L2, 0); w2.y = PK4(L2, 4); w2.z = PK4(L2, 8); w2.w = PK4(L2, 12);
#undef PK4
      *(LAS u32x4*)(wl + lane * 272) = w1; *(LAS u32x4*)(wl + lane * 272 + 16) = w2; }
    asm volatile("s_waitcnt lgkmcnt(0)" ::: "memory");
    int ev[8]; float gv[8];
#pragma unroll
    for (int t = 0; t < 8; ++t) { const unsigned ck = ct[t] ^ ((ct[t] ^ ct[8 + t]) & (0u - (unsigned)p));
        const unsigned i1 = *(const LAS unsigned char*)(wl + lane * 272 + ((ck >> 4) & 15u)), i2 = *(const LAS unsigned char*)(wl + lane * 272 + 16 + (ck & 15u));
        ev[t] = (int)(i1 * 128u + i2);
        gv[t] = __expf(key2f(ck & ~255u) - mx) * isum; }
    asm volatile("s_waitcnt lgkmcnt(0)" ::: "memory");
    *(int4*)(idx + ob) = make_int4(ev[0], ev[1], ev[2], ev[3]); *(int4*)(idx + ob + 4) = make_int4(ev[4], ev[5], ev[6], ev[7]);
    *(float4*)(gate + ob) = make_float4(gv[0], gv[1], gv[2], gv[3]); *(float4*)(gate + ob + 4) = make_float4(gv[4], gv[5], gv[6], gv[7]);
}

typedef float v2f __attribute__((ext_vector_type(2)));
DI float gelu_exact(float x) { return 0.5f * x * (1.f + erff(x * 0.70710678118654752f)); }
typedef unsigned u32x6 __attribute__((ext_vector_type(6)));
typedef unsigned u32x2 __attribute__((ext_vector_type(2)));
typedef float f32x32 __attribute__((ext_vector_type(32)));
constexpr int FP6_ROW = 1536;
DI unsigned fp6_code(float x) {
    const float a = fminf(fabsf(x), 7.5f);
    unsigned c = a < 1.f ? (unsigned)__builtin_rintf(a * 8.f) : ((__float_as_uint(a) + 0x80000u) >> 20) - 1008u;
    c = c > 31u ? 31u : c;
    return c | ((__float_as_uint(x) >> 26) & 32u);
}
typedef float f32x16 __attribute__((ext_vector_type(16)));
DI void fp6_encode_row(const f32x4 (&v)[8], float mx, unsigned char* __restrict__ dst, float* __restrict__ inv, int row, int lane) {
    int k = 2 - ((int)((__float_as_uint(mx) >> 23) & 255u) - 127); k = k > 100 ? 100 : (k < -100 ? -100 : k);
    const float sc = __uint_as_float((unsigned)(127 + k) << 23), isc = __uint_as_float((unsigned)(127 - k) << 23);
    f32x16 a, b;
#pragma unroll
    for (int i = 0; i < 16; ++i) { a[i] = v[(2 * i) >> 2][(2 * i) & 3] * sc; b[i] = v[(2 * i + 1) >> 2][(2 * i + 1) & 3] * sc; }
    const u32x6 w = __builtin_amdgcn_cvt_scalef32_2xpk16_fp6_f32(a, b, 1.0f);
    unsigned char* op = dst + ((size_t)(lane >> 3) * NEXP + row) * 192 + (lane & 7) * 24;
    *(u32x2*)op = (u32x2){w[0], w[1]}; *(u32x2*)(op + 8) = (u32x2){w[2], w[3]}; *(u32x2*)(op + 16) = (u32x2){w[4], w[5]};
    if (lane == 0) inv[row] = isc;
}
DI void convert_fp6_rows(Frame& F, const float* __restrict__ src, unsigned char* __restrict__ dst, float* __restrict__ inv, int rows, int wv, int nw, LAS unsigned char* wl) {
    if (wv >= rows) return;
    f32x4 v[8];
    { const float* rp = src + (size_t)wv * D + F.lane * 4;
#pragma unroll
      for (int q = 0; q < 8; ++q) v[q] = *(const f32x4*)(rp + q * 256); }
    for (int row = wv; row < rows; row += nw) {
        float mx = 0.f;
#pragma unroll
        for (int q = 0; q < 8; ++q) { const f32x4 t = v[q]; mx = fmaxf(mx, fmaxf(fmaxf(fabsf(t[0]), fabsf(t[1])), fmaxf(fabsf(t[2]), fabsf(t[3]))));
            const int c = (q * 64 + F.lane) * 4; *(LAS f32x4*)(wl + (c + 4 * (c >> 5)) * 4) = t; }
        { const int nr = row + nw < rows ? row + nw : row; const float* rp = src + (size_t)nr * D + F.lane * 4;
#pragma unroll
          for (int q = 0; q < 8; ++q) v[q] = *(const f32x4*)(rp + q * 256); }
        mx = wave_max(mx);
        asm volatile("s_waitcnt lgkmcnt(0)" ::: "memory");
        f32x4 r[8];
#pragma unroll
        for (int i = 0; i < 8; ++i) r[i] = *(const LAS f32x4*)(wl + (36 * F.lane + 4 * i) * 4);
        asm volatile("s_waitcnt lgkmcnt(0)" ::: "memory");
        fp6_encode_row(r, mx, dst, inv, row, F.lane);
    }
}
typedef __bf16 bf16x32_t __attribute__((ext_vector_type(32)));
typedef __bf16 bf16x2_t __attribute__((ext_vector_type(2)));
constexpr int FP6_SLICE = 192;
DI void peer_u_round(LAS unsigned char* wl, const bf16_t* __restrict__ x2b, const float* __restrict__ part2, const float* __restrict__ gpeer, const int* __restrict__ idx,
                     const unsigned char* __restrict__ eu, float* __restrict__ pd, int t0, int x, int lane) {
    asm volatile("" : "+v"(lane));
    const int g = lane >> 3, l8 = lane & 7, tok = t0 + g;
    LAS int* lidx = (LAS int*)wl;
#pragma unroll
    for (int i = 0; i < 4; ++i) *(LAS u32x4*)(wl + (i * 64 + lane) * 16) = *(const u32x4*)(idx + (size_t)t0 * 128 + (i * 64 + lane) * 4);
    float ss = 0.f;
    { const f32x4 p = *(const f32x4*)(part2 + (size_t)tok * 32 + l8 * 4); ss = (p[0] + p[1]) + (p[2] + p[3]); }
    ss += __shfl_xor(ss, 1); ss += __shfl_xor(ss, 2); ss += __shfl_xor(ss, 4);
    const float r = rsqrtf(ss * (1.f / D) + EPS);
    bf16x2_t hb[16];
    const int c0 = x * 256 + l8 * 32;
#pragma unroll
    for (int q = 0; q < 4; ++q) { const u32x4 w = *(const u32x4*)(x2b + (size_t)tok * D + c0 + q * 8); f32x4 a, b; pg8::up8(w, a, b);
        const f32x4 ga = *(const f32x4*)(gpeer + c0 + q * 8), gb = *(const f32x4*)(gpeer + c0 + q * 8 + 4);
        a = a * ga * r; b = b * gb * r;
        hb[q * 4] = __builtin_bit_cast(bf16x2_t, pg8::cvt_pk_bf16(a[0], a[1])); hb[q * 4 + 1] = __builtin_bit_cast(bf16x2_t, pg8::cvt_pk_bf16(a[2], a[3]));
        hb[q * 4 + 2] = __builtin_bit_cast(bf16x2_t, pg8::cvt_pk_bf16(b[0], b[1])); hb[q * 4 + 3] = __builtin_bit_cast(bf16x2_t, pg8::cvt_pk_bf16(b[2], b[3])); }
    asm volatile("s_waitcnt lgkmcnt(0)" ::: "memory");
    const unsigned char* ub = eu + (size_t)x * NEXP * FP6_SLICE + l8 * 24;
    float* pdo = pd + ((size_t)x * M + tok) * 128 + l8;
#define PU_LOAD(UU, j0) do { _Pragma("unroll") for (int jj = 0; jj < 8; ++jj) { const int e_ = lidx[g * 128 + (j0) + jj]; const unsigned char* up_ = ub + (size_t)e_ * FP6_SLICE; \
        const u32x4 ua_ = *(const u32x4*)up_; const u32x2 uc_ = *(const u32x2*)(up_ + 16); UU[jj] = (u32x6){ua_[0], ua_[1], ua_[2], ua_[3], uc_[0], uc_[1]}; } } while (0)
#define PU_COMP(UU, j0) do { float p[8]; \
        _Pragma("unroll") for (int jj = 0; jj < 8; ++jj) { const bf16x32_t uf = __builtin_amdgcn_cvt_scalef32_pk32_bf16_fp6(UU[jj], 1.0f); float a0 = 0.f, a1 = 0.f; \
            _Pragma("unroll") for (int k = 0; k < 16; k += 2) { a0 = __builtin_amdgcn_fdot2_f32_bf16((bf16x2_t){uf[2 * k], uf[2 * k + 1]}, hb[k], a0, false); \
                a1 = __builtin_amdgcn_fdot2_f32_bf16((bf16x2_t){uf[2 * k + 2], uf[2 * k + 3]}, hb[k + 1], a1, false); } \
            p[jj] = a0 + a1; __builtin_amdgcn_sched_barrier(0); } \
        const bool b0 = l8 & 1, b1 = l8 & 2, b2 = l8 & 4; \
        float q0 = (b0 ? p[1] : p[0]) + __shfl_xor(b0 ? p[0] : p[1], 1), q1 = (b0 ? p[3] : p[2]) + __shfl_xor(b0 ? p[2] : p[3], 1); \
        float q2 = (b0 ? p[5] : p[4]) + __shfl_xor(b0 ? p[4] : p[5], 1), q3 = (b0 ? p[7] : p[6]) + __shfl_xor(b0 ? p[6] : p[7], 1); \
        const float r0 = (b1 ? q1 : q0) + __shfl_xor(b1 ? q0 : q1, 2), r1 = (b1 ? q3 : q2) + __shfl_xor(b1 ? q2 : q3, 2); \
        pdo[j0] = (b2 ? r1 : r0) + __shfl_xor(b2 ? r0 : r1, 4); } while (0)
    u32x6 UA[8], UB[8];
    PU_LOAD(UA, 0);
#pragma unroll 1
    for (int j0 = 0; j0 < 112; j0 += 16) {
        PU_LOAD(UB, j0 + 8);
        PU_COMP(UA, j0);
        PU_LOAD(UA, j0 + 16);
        PU_COMP(UB, j0 + 8);
    }
    PU_LOAD(UB, 120);
    PU_COMP(UA, 112);
    PU_COMP(UB, 120);
#undef PU_LOAD
#undef PU_COMP
    asm volatile("s_waitcnt lgkmcnt(0)" ::: "memory");
}
DI void peer_act(Frame& F, const float* __restrict__ pd, const int* __restrict__ idx, const float* __restrict__ gate, const float* __restrict__ scu, const float* __restrict__ scv, float* __restrict__ act) {
    for (size_t i = (size_t)F.vcu * NTHR + F.tid; i < (size_t)M * 128; i += (size_t)F.G * NTHR) {
        float s = 0.f;
#pragma unroll
        for (int x = 0; x < 8; ++x) s += pd[(size_t)x * M * 128 + i];
        const int e = idx[i];
        act[i] = gelu_exact(s * scu[e]) * gate[i] * scv[e];
    }
}
DI void peer_v_round(LAS unsigned char* wl, const bf16_t* __restrict__ x2b, const int* __restrict__ idx, const float* __restrict__ act, const unsigned char* __restrict__ ev,
                     bf16_t* __restrict__ yb, float* __restrict__ ssq, int t0, int x, int lane) {
    asm volatile("" : "+v"(lane));
    const int g = lane >> 3, l8 = lane & 7, tok = t0 + g;
    LAS int* lidx = (LAS int*)wl; LAS float* lact = (LAS float*)(wl + 4096);
#pragma unroll
    for (int i = 0; i < 4; ++i) { *(LAS u32x4*)(wl + (i * 64 + lane) * 16) = *(const u32x4*)(idx + (size_t)t0 * 128 + (i * 64 + lane) * 4);
        *(LAS f32x4*)(wl + 4096 + (i * 64 + lane) * 16) = *(const f32x4*)(act + (size_t)t0 * 128 + (i * 64 + lane) * 4); }
    f32x32 o;
#pragma unroll
    for (int k = 0; k < 32; ++k) o[k] = 0.f;
    asm volatile("s_waitcnt vmcnt(0) lgkmcnt(0)" ::: "memory");
    const unsigned char* vb = ev + (size_t)x * NEXP * FP6_SLICE + l8 * 24;
#define PV_LOAD(VB, j0) do { _Pragma("unroll") for (int jj = 0; jj < 4; ++jj) { const int e_ = lidx[g * 128 + (j0) + jj]; \
        const unsigned char* vp_ = vb + (size_t)e_ * FP6_SLICE; const u32x4 va_ = *(const u32x4*)vp_; const u32x2 vc_ = *(const u32x2*)(vp_ + 16); \
        VB[jj] = (u32x6){va_[0], va_[1], va_[2], va_[3], vc_[0], vc_[1]}; } } while (0)
#define PV_ACC(VB, j0) do { _Pragma("unroll") for (int jj = 0; jj < 4; ++jj) { const f32x32 vf_ = __builtin_amdgcn_cvt_scalef32_pk32_f32_fp6(VB[jj], 1.0f); \
        o += vf_ * lact[g * 128 + (j0) + jj]; __builtin_amdgcn_sched_barrier(0); } } while (0)
    u32x6 vA[4], vB[4];
    PV_LOAD(vA, 0);
#pragma unroll 1
    for (int j0 = 0; j0 < 120; j0 += 8) {
        PV_LOAD(vB, j0 + 4);
        PV_ACC(vA, j0);
        PV_LOAD(vA, j0 + 8);
        PV_ACC(vB, j0 + 4);
    }
    PV_LOAD(vB, 124);
    PV_ACC(vA, 120);
    PV_ACC(vB, 124);
#undef PV_LOAD
#undef PV_ACC
    const int c0 = x * 256 + l8 * 32; float ss = 0.f;
#pragma unroll
    for (int q = 0; q < 4; ++q) { const u32x4 w = *(const u32x4*)(x2b + (size_t)tok * D + c0 + q * 8); f32x4 ta, tb; pg8::up8(w, ta, tb);
        const f32x4 ya = {o[q * 8] + ta[0], o[q * 8 + 1] + ta[1], o[q * 8 + 2] + ta[2], o[q * 8 + 3] + ta[3]}, yb_ = {o[q * 8 + 4] + tb[0], o[q * 8 + 5] + tb[1], o[q * 8 + 6] + tb[2], o[q * 8 + 7] + tb[3]};
        *(u32x4*)(yb + (size_t)tok * D + c0 + q * 8) = pg8::pack8(ya, yb_);
        ss += (ya[0] * ya[0] + ya[1] * ya[1]) + (ya[2] * ya[2] + ya[3] * ya[3]) + (yb_[0] * yb_[0] + yb_[1] * yb_[1]) + (yb_[2] * yb_[2] + yb_[3] * yb_[3]); }
    ss += __shfl_xor(ss, 1); ss += __shfl_xor(ss, 2); ss += __shfl_xor(ss, 4);
    if (l8 == 0) ssq[(size_t)tok * 8 + x] = ss;
    asm volatile("s_waitcnt lgkmcnt(0)" ::: "memory");
}
DI void peer_norm_rows(Frame& F, const bf16_t* __restrict__ yb, float* __restrict__ out, const float* __restrict__ ssq, const float* __restrict__ gfin) {
    for (int row0 = F.gw * 2; row0 < M; row0 += F.NGW * 2) {
        u32x4 w[2][4]; float r[2];
#pragma unroll
        for (int i = 0; i < 2; ++i) { const int row = row0 + i;
#pragma unroll
            for (int j = 0; j < 4; ++j) w[i][j] = *(const u32x4*)(yb + (size_t)row * D + (F.lane + 64 * j) * 8);
            const f32x4 s0 = *(const f32x4*)(ssq + (size_t)row * 8), s1 = *(const f32x4*)(ssq + (size_t)row * 8 + 4);
            r[i] = rsqrtf(((s0[0] + s0[1]) + (s0[2] + s0[3]) + (s1[0] + s1[1]) + (s1[2] + s1[3])) * (1.f / D) + EPS); }
#pragma unroll
        for (int i = 0; i < 2; ++i)
#pragma unroll
            for (int j = 0; j < 4; ++j) { f32x4 a, b; pg8::up8(w[i][j], a, b);
                const f32x4 ga = *(const f32x4*)(gfin + (F.lane + 64 * j) * 8), gb = *(const f32x4*)(gfin + (F.lane + 64 * j) * 8 + 4);
                float* op = out + (size_t)(row0 + i) * D + (F.lane + 64 * j) * 8;
                *(f32x4*)op = a * ga * r[i]; *(f32x4*)(op + 4) = b * gb * r[i]; }
    }
}

template <class Sched> DI void build_rtab(Frame& F, const Sched& S, const float* part) {
    LAS float* rt = (LAS float*)(F.lds + SPARE_OFF);
    pg8::Unit u;
    for (int i = 0; i < 12 && S.next(i, u); ++i) {
        if (F.tid < 256) { const float4* pp = (const float4*)(part + (size_t)(u.pm * 256 + F.tid) * 32); float s = 0.f;
#pragma unroll
            for (int j = 0; j < 8; ++j) { const float4 v = pp[j]; s += (v.x + v.y) + (v.z + v.w); }
            rt[i * 256 + F.tid] = rsqrtf(s * (1.f / D) + EPS); }
    }
    __syncthreads();
}

constexpr int CW_BAR = 4096;
#define PH(k)
__global__ void __launch_bounds__(NTHR, 2) mega_fwd(Args args) {
    extern __shared__ __attribute__((aligned(16))) unsigned char lds_raw[];
    Frame F;
    F.lds = (LAS unsigned char*)lds_raw; F.ldsg = lds_raw;
    F.tid = threadIdx.x; F.lane = F.tid & 63; F.wave = __builtin_amdgcn_readfirstlane(F.tid >> 6);
    F.G = gridDim.x; { const int bx = blockIdx.x; F.vcu = (F.G % 8 == 0) ? (bx % 8) * (F.G / 8) + bx / 8 : bx; }
    F.gw = F.vcu * NWAVES + F.wave; F.NGW = F.G * NWAVES;
    volatile LAS unsigned* MISC = (volatile LAS unsigned*)(F.lds + MISC_OFF);
    if (F.tid < 64) MISC[F.tid] = 0u;
    __syncthreads();
    unsigned* ctl = (unsigned*)(args.ws + WS_CTL);
    XcdBarrier bar = xcd_barrier_post(ctl + CW_BAR, MISC + 8);
    const int c = (int)blockIdx.x, G = F.G;
    using pg8::SchedStd; using pg8::SchedOne; using pg8::Unit;

    PH(0) p0_prologue(F, args);
    xcd_barrier(bar);

    PH(1) {
        SchedStd S{(const char*)WB(WS_H1), (const char*)WB(WS_WINT), nullptr, nullptr, 2048, 2048, 64, 40, G, c, 1 << 20, 0, 0};
        pg8::EpiProj E{WB(WS_PROJA), WB(WS_PROJG)};
        pg8::gemm_phase<pg8::EpiProj, SchedStd, true>(F.lds, 2048, 2048, 2048, S, E);
    }
    PH(10) {
        SchedStd S{(const char*)WB(WS_MEMN), (const char*)WB(WS_WKVT), nullptr, nullptr, 2048, 2048, 4, 16, G, c, 1 << 20, 0, 0};
        pg8::EpiBf E{WB(WS_KVM), 4096};
        pg8::gemm_phase<pg8::EpiBf, SchedStd, true>(F.lds, 2048, 2048, 2048, S, E);
    }
    PH(11) {
        SchedOne S; S.have = (c >= 64 && c < 128); const int j = (c - 64) & 63, pmj = j >> 3, pn = j & 7;
        S.u0.pm = pmj; S.u0.pn = pn; S.u0.idx = 0; S.u0.s = 0;
        S.u0.a = (const char*)(WB(WS_AKEYS) + (size_t)pmj * 256 * 256); S.u0.b = (const char*)(WB(WS_WPQN) + (size_t)pn * 256 * 2048 + pmj * 256);
        pg8::EpiBf E{WB(WS_WPPT), 2048};
        pg8::gemm_phase<pg8::EpiBf, SchedOne, true>(F.lds, 256, 2048, 256, S, E);
    }
    if (c >= 64 && G > 64) convert_fp6_rows(F, args.in[19], args.ws + WS_EU, WF(WS_SCU), NEXP, (c - 64) * NWAVES + F.wave, (G - 64) * NWAVES, F.lds + F.wave * 17408);
    xcd_barrier(bar);

    PH(2) for (int i = 0; i < 2; ++i) { const int unit = F.vcu * 2 + i; if (unit < 512) battn_unit(F.lds, WB(WS_PROJA), args.in[6], WB(WS_OATT), unit); }
    PH(12) for (int gid = F.vcu * NTHR + F.tid; gid < (M / 16) * 128; gid += G * NTHR) conv_item(WB(WS_PROJA), args.in[4], args.in[5], WB(WS_YC), gid);
    PH(13) {
        SchedOne S; S.have = (c < 256); S.u0.idx = 0; S.u0.s = 0;
        const int j = c & 127, b = j >> 5, head = (j >> 3) & 3, t8 = j & 7;
        if (c < 128) {
            S.u0.pm = b * 4 + head; S.u0.pn = t8;
            S.u0.a = (const char*)(WB(WS_KVM) + (size_t)(b * 256) * 4096 + head * 512); S.u0.b = (const char*)(WB(WS_WCQN) + (size_t)(t8 * 256) * 2048 + head * 512);
            pg8::EpiBf E{WB(WS_WST), 2048};
            pg8::gemm_phase<pg8::EpiBf, SchedOne, true>(F.lds, 4096, 2048, 512, S, E);
        } else {
            S.u0.pm = b * 8 + t8; S.u0.pn = head;
            S.u0.a = (const char*)(WB(WS_WCOT) + (size_t)(t8 * 256) * 2048 + head * 512); S.u0.b = (const char*)(WB(WS_KVM) + (size_t)(b * 256) * 4096 + 2048 + head * 512);
            pg8::EpiBf E{WB(WS_WOT), 1024};
            pg8::gemm_phase<pg8::EpiBf, SchedOne, true>(F.lds, 2048, 4096, 512, S, E);
        }
    }
    xcd_barrier(bar);

    PH(3) {
        SchedStd S{(const char*)WB(WS_OATT), (const char*)WB(WS_WATT), (const char*)WB(WS_YC), (const char*)WB(WS_WCONV), 1024, 1024, 64, 8, G, c, 1 << 20, 1, 0};
        pg8::EpiMerge E{WB(WS_PROJG), WB(WS_SCR), WB(WS_MERGED)};
        pg8::gemm_phase<pg8::EpiMerge, SchedStd, true>(F.lds, 1024, 1024, 1024, S, E);
    }
    xcd_barrier(bar);

    PH(4) {
        SchedStd S{(const char*)WB(WS_MERGED), (const char*)WB(WS_WMIX), nullptr, nullptr, 2048, 2048, 64, 8, G, c, 1 << 20, 0, 0};
        pg8::EpiRes<false> E{args.in[0], WB(WS_X1BF), WF(WS_PART1)};
        pg8::gemm_phase<pg8::EpiRes<false>, SchedStd, true>(F.lds, 2048, 2048, 2048, S, E);
    }
    xcd_barrier(bar);

    PH(5) {
        SchedStd S{(const char*)WB(WS_X1BF), (const char*)WB(WS_WST), nullptr, nullptr, 2048, 2048, 64, 4, G, c, 16, 0, (size_t)1024 * 2048 * 2};
        build_rtab(F, S, WF(WS_PART1));
        pg8::EpiSoftmax E{WB(WS_PB), (const LAS float*)(F.lds + SPARE_OFF)};
        pg8::gemm_phase<pg8::EpiSoftmax, SchedStd, false>(F.lds, 2048, 2048, 2048, S, E);
    }
    xcd_barrier(bar);

    PH(6) {
        SchedStd S{(const char*)WB(WS_PB), (const char*)WB(WS_WOT), nullptr, nullptr, 1024, 1024, 64, 8, G, c, 16, 0, (size_t)2048 * 1024 * 2};
        pg8::EpiRes<true> E{WB(WS_X1BF), WB(WS_X2BF), WF(WS_PART2)};
        pg8::gemm_phase<pg8::EpiRes<true>, SchedStd, true>(F.lds, 1024, 1024, 1024, S, E);
    }
    xcd_barrier(bar);

    PH(7) {
        SchedStd S{(const char*)WB(WS_X2BF), (const char*)WB(WS_WPPT), nullptr, nullptr, 2048, 2048, 64, 8, G, c, 1 << 20, 0, 0};
        build_rtab(F, S, WF(WS_PART2));
        pg8::EpiScore E{WF(WS_SCORES), (const LAS float*)(F.lds + SPARE_OFF)};
        pg8::gemm_phase<pg8::EpiScore, SchedStd, true>(F.lds, 2048, 2048, 2048, S, E);
    }
    xcd_barrier(bar);

    PH(8) for (int it = F.gw; it < M / 4; it += F.NGW) topk_item4(WF(WS_SCORES), (int*)(args.ws + WS_IDX), WF(WS_GATE), it, F.lds + F.wave * 17408, F.lane);
    PH(14) { if (G <= 64) convert_fp6_rows(F, args.in[19], args.ws + WS_EU, WF(WS_SCU), NEXP, F.gw, F.NGW, F.lds + F.wave * 17408);
    convert_fp6_rows(F, args.in[20], args.ws + WS_EV, WF(WS_SCV), NEXP, F.gw, F.NGW, F.lds + F.wave * 17408); }
    xcd_barrier(bar);

    const int xv = c & 7, wx = (c >> 3) * NWAVES + F.wave, nwx = (G >> 3) * NWAVES;
    PH(9) for (int t0 = wx * 8; t0 < M; t0 += nwx * 8)
        peer_u_round(F.lds + F.wave * 8192, WB(WS_X2BF), WF(WS_PART2), args.in[16], (const int*)(args.ws + WS_IDX), args.ws + WS_EU, WF(WS_PD), t0, xv, F.lane);
    xcd_barrier(bar);
    PH(15) peer_act(F, WF(WS_PD), (const int*)(args.ws + WS_IDX), WF(WS_GATE), WF(WS_SCU), WF(WS_SCV), WF(WS_ACT));
    xcd_barrier(bar);
    PH(16) for (int t0 = wx * 8; t0 < M; t0 += nwx * 8)
        peer_v_round(F.lds + F.wave * 8192, WB(WS_X2BF), (const int*)(args.ws + WS_IDX), WF(WS_ACT), args.ws + WS_EV, WB(WS_YB), WF(WS_SSQ), t0, xv, F.lane);
    xcd_barrier(bar);
    PH(17) peer_norm_rows(F, WB(WS_YB), args.out, WF(WS_SSQ), args.in[21]);
}

extern "C" void kernel_launch(void* const* d_in, const int* in_sizes, int n_in, void* d_out, int out_size, void* d_ws, size_t ws_size, hipStream_t stream) {
    static int grid = 0;
    if (grid == 0) {
        if (n_in != 22 || ws_size < WS_END) { fprintf(stderr, "kernel_launch: unexpected n_in %d or ws_size %zu (< %zu)\n", n_in, ws_size, (size_t)WS_END); grid = -1; return; }
        int dev = 0, cus = 0, per_cu = 0;
        if (hipGetDevice(&dev) != hipSuccess || hipDeviceGetAttribute(&cus, hipDeviceAttributeMultiprocessorCount, dev) != hipSuccess) { grid = -1; return; }
        if (hipFuncSetAttribute((const void*)mega_fwd, hipFuncAttributeMaxDynamicSharedMemorySize, LDS_BYTES) != hipSuccess) { fprintf(stderr, "kernel_launch: hipFuncSetAttribute failed\n"); grid = -1; return; }
        if (hipOccupancyMaxActiveBlocksPerMultiprocessor(&per_cu, (const void*)mega_fwd, NTHR, LDS_BYTES) != hipSuccess || per_cu < 1) { fprintf(stderr, "kernel_launch: occupancy query says %d\n", per_cu); per_cu = 1; }
        (void)hipGetLastError();
        grid = cus;
        if (grid > 256) grid = 256;
    }
    if (grid < 0) return;
    (void)hipMemsetAsync((char*)d_ws + WS_CTL, 0, 65536, stream);
    Args a{};
    for (int i = 0; i < 22; ++i) a.in[i] = (const float*)d_in[i];
    a.out = (float*)d_out; a.ws = (unsigned char*)d_ws;
    void* kargs[] = {&a};
    hipError_t e = hipLaunchCooperativeKernel((const void*)mega_fwd, dim3(grid), dim3(NTHR), kargs, LDS_BYTES, stream);
    if (e != hipSuccess) fprintf(stderr, "kernel_launch: cooperative launch failed: %s (grid %d)\n", hipGetErrorString(e), grid);
}
```

```cpp
#include <hip/hip_runtime.h>
#include <cstdio>
#include <cstdint>

#define DI __device__ __forceinline__
#define LAS __attribute__((address_space(3)))
#define GAS __attribute__((address_space(1)))
typedef unsigned short bf16_t;
typedef short bf16x8 __attribute__((ext_vector_type(8)));
typedef float f32x4 __attribute__((ext_vector_type(4)));
typedef unsigned u32x4 __attribute__((ext_vector_type(4)));
typedef unsigned u32x2 __attribute__((ext_vector_type(2)));
typedef float f32x2v __attribute__((ext_vector_type(2)));

constexpr int D = 2048, NB = 4, SEQ = 4096, M = NB * SEQ;
constexpr int INC = 10240, PA = 6144, PG = 4096;
constexpr int MROWS = 1024;
constexpr int NEXP = 16384;
constexpr float EPS = 1e-6f;
constexpr int NWAVES = 8, NTHR = 512;

constexpr size_t MiB = 1u << 20;
constexpr size_t WS_CTL = 0;
constexpr size_t WS_WINT = 1 * MiB;
constexpr size_t WS_WKVT = 41 * MiB;
constexpr size_t WS_WATT = 57 * MiB;
constexpr size_t WS_WCONV = 61 * MiB;
constexpr size_t WS_WMIX = 65 * MiB;
constexpr size_t WS_WCOT = 73 * MiB;
constexpr size_t WS_WCQN = 81 * MiB;
constexpr size_t WS_WPPT = 89 * MiB;
constexpr size_t WS_WST = 97 * MiB;
constexpr size_t WS_WOT = 113 * MiB;
constexpr size_t WS_MEMN = 129 * MiB;
constexpr size_t WS_KVM = 133 * MiB;
constexpr size_t WS_H1 = 141 * MiB;
constexpr size_t WS_OATT = 141 * MiB;
constexpr size_t WS_YC = 173 * MiB;
constexpr size_t WS_X1BF = 141 * MiB;
constexpr size_t WS_X2BF = 141 * MiB;
constexpr size_t WS_EU = 535 * MiB;
constexpr size_t WS_EV = 559 * MiB;
constexpr size_t WS_SCU = 583 * MiB;
constexpr size_t WS_SCV = 583 * MiB + 65536;
constexpr size_t WS_SSQ = 21 * MiB + 131072;
constexpr size_t WS_ACT = 22 * MiB;
constexpr size_t WS_YB = 269 * MiB;
constexpr size_t WS_PD = 205 * MiB;
constexpr size_t WS_PROJA = 205 * MiB;
constexpr size_t WS_MERGED = 205 * MiB;
constexpr size_t WS_PB = 205 * MiB;
constexpr size_t WS_SCR = 269 * MiB;
constexpr size_t WS_X2F = 269 * MiB;
constexpr size_t WS_PROJG = 397 * MiB;
constexpr size_t WS_X1F = 397 * MiB;
constexpr size_t WS_SCORES = 397 * MiB;
constexpr size_t WS_AKEYS = 525 * MiB;
constexpr size_t WS_WPQN = 526 * MiB;
constexpr size_t WS_END = 584 * MiB;
constexpr size_t WS_PART1 = 1 * MiB;
constexpr size_t WS_PART2 = 3 * MiB;
constexpr size_t WS_IDX = 5 * MiB;
constexpr size_t WS_GATE = 13 * MiB;

constexpr int RING_BYTES = 131072;
constexpr int SPARE_OFF = RING_BYTES;
constexpr int MISC_OFF = RING_BYTES + 12288;
constexpr int LDS_BYTES = 147456;

DI float bf2f(unsigned v) { return __uint_as_float(v << 16); }
DI unsigned f2bf(float f) { unsigned u = __float_as_uint(f); return (u + 0x7fffu + ((u >> 16) & 1u)) >> 16; }
DI unsigned pk2(float lo, float hi) { unsigned r; asm("v_cvt_pk_bf16_f32 %0, %1, %2" : "=v"(r) : "v"(lo), "v"(hi)); return r; }
DI float wave_sum(float v) {
#pragma unroll
    for (int o = 1; o < 64; o <<= 1) v += __shfl_xor(v, o);
    return v;
}
DI float wave_max(float v) {
#pragma unroll
    for (int o = 1; o < 64; o <<= 1) v = fmaxf(v, __shfl_xor(v, o));
    return v;
}
DI void unpack8(const uint4 v, float* o) { o[0] = bf2f(v.x & 0xffffu); o[1] = bf2f(v.x >> 16); o[2] = bf2f(v.y & 0xffffu); o[3] = bf2f(v.y >> 16); o[4] = bf2f(v.z & 0xffffu); o[5] = bf2f(v.z >> 16); o[6] = bf2f(v.w & 0xffffu); o[7] = bf2f(v.w >> 16); }

#define XB_TMO      128
#define XB_XCNT(j)  (256  + 64 * (j))
#define XB_XSUB(j)  (1280 + 64 * (j))
#define XB_XGEN(j)  (2304 + 64 * (j))
#define XB_TOP      3328
#define XB_TOPGEN   3392
#define XCD_BAR_WORDS 3456
#define XB_SPIN_CAP (1u << 20)
DI unsigned xb_ld(unsigned* p)              { return __hip_atomic_load(p, __ATOMIC_RELAXED, __HIP_MEMORY_SCOPE_AGENT); }
DI unsigned xb_add(unsigned* p, unsigned v) { return __hip_atomic_fetch_add(p, v, __ATOMIC_RELAXED, __HIP_MEMORY_SCOPE_AGENT); }
DI unsigned xb_xcc_id() { return (unsigned)__builtin_amdgcn_s_getreg((3 << 11) | 20) & 0xFu; }
#define XB_SPIN(cond, bar) do { unsigned _sp = 0; while (cond) { __builtin_amdgcn_s_sleep(1); \
    if ((++_sp & 255u) == 0u) { if (xb_ld(&(bar)[XB_TMO])) break; if (_sp > XB_SPIN_CAP) { atomicAdd(&(bar)[XB_TMO], 1u); break; } } } } while (0)
struct XcdBarrier { unsigned* bar; unsigned x; volatile LAS unsigned* st; };
DI XcdBarrier xcd_barrier_post(unsigned* bar, volatile LAS unsigned* st) {
    XcdBarrier b; b.bar = bar; b.x = xb_xcc_id(); b.st = st;
    if (threadIdx.x == 0) (void)xb_add(&bar[XB_XCNT(b.x)], 1u);
    return b;
}
DI void xcd_barrier_complete(unsigned* bar, unsigned x, unsigned& nloc, unsigned& nx) {
    const unsigned G = gridDim.x;
    unsigned sum, cnt, mine, sp = 0u;
    for (;;) {
        sum = 0u; cnt = 0u; mine = 0u;
#pragma unroll
        for (unsigned j = 0; j < 16; ++j) { const unsigned c = xb_ld(&bar[XB_XCNT(j)]); sum += c; cnt += (c > 0u) ? 1u : 0u; mine = (j == x) ? c : mine; }
        if (sum == G) break;
        __builtin_amdgcn_s_sleep(1);
        if ((++sp & 255u) == 0u) { if (xb_ld(&bar[XB_TMO])) break; if (sp > XB_SPIN_CAP) { atomicAdd(&bar[XB_TMO], 1u); break; } }
    }
    nloc = mine > 0u ? mine : 1u; nx = cnt > 0u ? cnt : 1u;
}
DI void xcd_barrier(const XcdBarrier& b) {
    asm volatile("s_waitcnt vmcnt(0)" ::: "memory");
    __syncthreads();
    if (threadIdx.x == 0) {
        unsigned* bar = b.bar;
        __builtin_amdgcn_s_waitcnt(0);
        unsigned nloc = b.st[0], nx = b.st[1];
        if (nloc == 0u) { xcd_barrier_complete(bar, b.x, nloc, nx); b.st[0] = nloc; b.st[1] = nx; }
        const unsigned old = xb_add(&bar[XB_XSUB(b.x)], 1u);
        const unsigned gen = old / nloc;
        if (old + 1u == (gen + 1u) * nloc) {
            __builtin_amdgcn_fence(__ATOMIC_RELEASE, "agent");
            asm volatile("s_waitcnt vmcnt(0)" ::: "memory");
            const unsigned og = xb_add(&bar[XB_TOP], 1u);
            const unsigned tg = og / nx;
            if (og + 1u == (tg + 1u) * nx) xb_add(&bar[XB_TOPGEN], 1u);
            else XB_SPIN(xb_ld(&bar[XB_TOPGEN]) == tg, bar);
            __builtin_amdgcn_fence(__ATOMIC_ACQUIRE, "agent");
            xb_add(&bar[XB_XGEN(b.x)], 1u);
            asm volatile("s_waitcnt vmcnt(0)" ::: "memory");
        } else {
            XB_SPIN(xb_ld(&bar[XB_XGEN(b.x)]) == gen, bar);
            __builtin_amdgcn_fence(__ATOMIC_ACQUIRE, "agent");
            asm volatile("s_waitcnt vmcnt(0)" ::: "memory");
        }
    }
    __syncthreads();
}

namespace pg8 {
constexpr int BM = 256, BK = 64, HALF = 128, HTB = HALF * BK * 2, NXCD = 8, WGM = 2;
DI int lds_byte(int r, int c) { const int st = (r >> 4) * 2 + (c >> 5), rr = r & 15, cc = c & 31, ob = rr * 64 + cc * 2; return st * 1024 + (ob ^ (((ob >> 9) & 1) << 5)); }
DI void stage_rc(int b, int& R, int& C) { const int st = b / 1024, sb = b % 1024, swz = sb ^ (((sb >> 9) & 1) << 5); R = (st >> 1) * 16 + swz / 64; C = (st & 1) * 32 + (swz % 64) / 2; }
DI int perm32(int rho) { const int n = rho >> 4, i = rho & 15; return 8 * (i >> 2) + 4 * n + (i & 3); }
struct Unit { int pm, pn, idx, s; const char* a; const char* b; };
DI void tile_of(int L, int nM, int nN, int& pm, int& pn) {
    const int nwg = nM * nN; int wgid = L;
    { const int q = nwg / NXCD, r = nwg % NXCD, xcd = wgid % NXCD, off = wgid / NXCD; wgid = (xcd < r ? xcd * (q + 1) : r * (q + 1) + (xcd - r) * q) + off; }
    const int nig = WGM * nN, gid = wgid / nig, fm = gid * WGM, gsz = (nM - fm) < WGM ? (nM - fm) : WGM;
    pm = fm + ((wgid % nig) % gsz); pn = (wgid % nig) / gsz;
}
template <class Epi, class Sched, bool ALIGN_EPI>
DI void gemm_phase(LAS unsigned char* lds, const int lda, const int ldb, const int K, const Sched& S, const Epi& E) {
    int tid = threadIdx.x; asm volatile("" : "+v"(tid));
    const int wid = __builtin_amdgcn_readfirstlane(tid >> 6), lane = tid & 63, wr = wid >> 2, wc = wid & 3, fr = lane & 15, fq = lane >> 4;
    const int nt = K / BK;
    unsigned voffA[2], voffB[2];
#pragma unroll
    for (int i = 0; i < 2; ++i) { int R, C; stage_rc(tid * 16 + i * 8192, R, C); const int Rb = (R & ~31) + perm32(R & 31);
        voffA[i] = (unsigned)(R * lda + C) * 2u; voffB[i] = (unsigned)(Rb * ldb + C) * 2u; }
    const size_t kstep = (size_t)(BK * 2);
    const size_t hA = (size_t)HALF * lda * 2, hB = (size_t)HALF * ldb * 2;
    const unsigned ldsw = (unsigned)wid * 1024u;
    const int aoff = lds_byte(wr * 64 + fr, fq * 8), boff = lds_byte(wc * 32 + fr, fq * 8);
#define PG8_SA(b, h) (((b) * 2 + (h)) * HTB)
#define PG8_SB(b, h) ((4 + (b) * 2 + (h)) * HTB)
#define PG8_STAGE(bufoff, gbase, voff) do { _Pragma("unroll") for (int _i = 0; _i < 2; ++_i) \
        __builtin_amdgcn_global_load_lds((const unsigned*)((const char*)(gbase) + (voff)[_i]), (LAS unsigned*)(lds + (bufoff) + ldsw + _i * 8192), 16, 0, 0); } while (0)
#define PG8_LDA(dst, b, h) do { _Pragma("unroll") for (int m = 0; m < 4; ++m) _Pragma("unroll") for (int k = 0; k < 2; ++k) dst[m][k] = *(const LAS bf16x8*)(lds + PG8_SA(b, h) + aoff + m * 2048 + k * 1024); } while (0)
#define PG8_LDB(dst, b, h) do { _Pragma("unroll") for (int n = 0; n < 2; ++n) _Pragma("unroll") for (int k = 0; k < 2; ++k) dst[n][k] = *(const LAS bf16x8*)(lds + PG8_SB(b, h) + boff + n * 2048 + k * 1024); } while (0)
#define PG8_MMA(ai, bj, At, Bt) do { __builtin_amdgcn_s_setprio(1); _Pragma("unroll") for (int m = 0; m < 4; ++m) _Pragma("unroll") for (int n = 0; n < 2; ++n) _Pragma("unroll") for (int k = 0; k < 2; ++k) \
        acc[ai][bj][m][n] = __builtin_amdgcn_mfma_f32_16x16x32_bf16(Bt[n][k], At[m][k], acc[ai][bj][m][n], 0, 0, 0); __builtin_amdgcn_s_setprio(0); } while (0)
#define PG8_WAIT_V(n) asm volatile("s_waitcnt vmcnt(" #n ")" ::: "memory")
#define PG8_WAIT_L(n) asm volatile("s_waitcnt lgkmcnt(" #n ")" ::: "memory")
#define PG8_BAR __builtin_amdgcn_s_barrier()
#define PG8_SCHED __builtin_amdgcn_sched_barrier(0)
    Unit cur, nxt; int ui = 0;
    if (!S.next(0, cur)) return;
    f32x4 acc[2][2][4][2];
#pragma unroll
    for (int a = 0; a < 2; ++a)
#pragma unroll
        for (int b = 0; b < 2; ++b)
#pragma unroll
            for (int m = 0; m < 4; ++m)
#pragma unroll
                for (int n = 0; n < 2; ++n) acc[a][b][m][n] = (f32x4){0.f, 0.f, 0.f, 0.f};
    bf16x8 At[4][2], B0[2][2], B1[2][2];
    const char* cA = cur.a; const char* cB = cur.b;
    PG8_STAGE(PG8_SB(0, 0), cB, voffB); PG8_STAGE(PG8_SB(0, 1), cB + hB, voffB); PG8_STAGE(PG8_SA(0, 0), cA, voffA); PG8_STAGE(PG8_SA(0, 1), cA + hA, voffA);
    if (wr == 1) PG8_BAR;
    PG8_WAIT_V(2); PG8_BAR;
    PG8_STAGE(PG8_SB(1, 0), cB + kstep, voffB); PG8_STAGE(PG8_SA(1, 0), cA + kstep, voffA); PG8_STAGE(PG8_SB(1, 1), cB + hB + kstep, voffB);
    PG8_WAIT_V(6); PG8_BAR;
    for (;;) {
        const bool has_next = S.next(ui + 1, nxt);
        const char* nA = has_next ? nxt.a : cA; const char* nB = has_next ? nxt.b : cB;
        for (int t = 0; t < nt; t += 2) {
            const bool last = (t == nt - 2);
            const char* a1 = cA + (size_t)(t + 1) * kstep;
            const char* a2 = last ? nA : cA + (size_t)(t + 2) * kstep; const char* b2 = last ? nB : cB + (size_t)(t + 2) * kstep;
            const char* a3 = a2 + kstep; const char* b3 = b2 + kstep;
            PG8_LDB(B0, 0, 0); PG8_LDB(B1, 0, 1); PG8_SCHED; PG8_LDA(At, 0, 0); PG8_STAGE(PG8_SA(1, 1), a1 + hA, voffA);
            PG8_WAIT_V(8); PG8_WAIT_L(0); PG8_BAR; PG8_MMA(0, 0, At, B0); PG8_MMA(0, 1, At, B1); PG8_BAR; PG8_SCHED;
            PG8_LDA(At, 0, 1); PG8_STAGE(PG8_SB(0, 0), b2, voffB); PG8_STAGE(PG8_SB(0, 1), b2 + hB, voffB); PG8_STAGE(PG8_SA(0, 0), a2, voffA);
            PG8_WAIT_V(8); PG8_WAIT_L(0); PG8_BAR; PG8_MMA(1, 0, At, B0); PG8_MMA(1, 1, At, B1); PG8_BAR; PG8_SCHED;
            PG8_LDB(B0, 1, 0); PG8_LDB(B1, 1, 1); PG8_SCHED; PG8_LDA(At, 1, 0); PG8_STAGE(PG8_SA(0, 1), a2 + hA, voffA);
            PG8_WAIT_V(8); PG8_WAIT_L(0); PG8_BAR; PG8_MMA(0, 0, At, B0); PG8_MMA(0, 1, At, B1); PG8_BAR; PG8_SCHED;
            PG8_LDA(At, 1, 1); PG8_STAGE(PG8_SB(1, 0), b3, voffB); PG8_STAGE(PG8_SB(1, 1), b3 + hB, voffB); PG8_STAGE(PG8_SA(1, 0), a3, voffA);
            PG8_WAIT_V(8); PG8_WAIT_L(0); PG8_BAR; PG8_MMA(1, 0, At, B0); PG8_MMA(1, 1, At, B1); PG8_BAR; PG8_SCHED;
        }
        if constexpr (ALIGN_EPI) { if (wr == 0) PG8_BAR; }
        if constexpr (!Epi::AFTER_DRAIN) { E(acc, cur, wr, wc, fr, fq); }
        if (!has_next) break;
#pragma unroll
        for (int a = 0; a < 2; ++a)
#pragma unroll
            for (int b = 0; b < 2; ++b)
#pragma unroll
                for (int m = 0; m < 4; ++m)
#pragma unroll
                    for (int n = 0; n < 2; ++n) acc[a][b][m][n] = (f32x4){0.f, 0.f, 0.f, 0.f};
        cur = nxt; cA = nA; cB = nB; ++ui;
        if constexpr (ALIGN_EPI) { if (wr == 1) PG8_BAR; }
    }
    PG8_WAIT_V(0);
    if constexpr (!ALIGN_EPI) { if (wr == 0) PG8_BAR; }
    PG8_BAR;
    if constexpr (Epi::AFTER_DRAIN) { E.fused(acc, cur, wr, wc, fr, fq, lds, wid, lane); }
#undef PG8_SA
#undef PG8_SB
#undef PG8_STAGE
#undef PG8_LDA
#undef PG8_LDB
#undef PG8_MMA
#undef PG8_WAIT_V
#undef PG8_WAIT_L
#undef PG8_BAR
#undef PG8_SCHED
}

struct SchedStd {
    const char* A0; const char* B0; const char* A1; const char* B1; int lda, ldb, nM, nN, G, c, pm_per_batch, dual; size_t bstride;
    DI bool next(int i, Unit& u) const {
        const int ti = dual ? (i >> 1) : i; const long L = (long)ti * G + c; if (L >= (long)nM * nN) return false;
        { int pm_, pn_; tile_of((int)L, nM, nN, pm_, pn_); u.pm = __builtin_amdgcn_readfirstlane(pm_); u.pn = __builtin_amdgcn_readfirstlane(pn_); } u.idx = i; u.s = dual ? (i & 1) : 0;
        const char* A = u.s ? A1 : A0; const char* B = u.s ? B1 : B0;
        u.a = A + (size_t)u.pm * 256 * lda * 2; u.b = B + (size_t)u.pn * 256 * ldb * 2 + (size_t)(u.pm / pm_per_batch) * bstride;
        return true;
    }
};
struct SchedOne {
    int have; Unit u0;
    DI bool next(int i, Unit& u) const { if (i != 0 || !have) return false; u = u0; return true; }
};

DI unsigned cvt_pk_bf16(float lo, float hi) { unsigned r; asm volatile("v_cvt_pk_bf16_f32 %0, %1, %2" : "=v"(r) : "v"(lo), "v"(hi)); return r; }
DI u32x4 pack8(const f32x4 v0, const f32x4 v1) { u32x4 w; w.x = cvt_pk_bf16(v0[0], v0[1]); w.y = cvt_pk_bf16(v0[2], v0[3]); w.z = cvt_pk_bf16(v1[0], v1[1]); w.w = cvt_pk_bf16(v1[2], v1[3]); return w; }
DI float sig1(float v) { return __builtin_amdgcn_rcpf(1.f + __builtin_amdgcn_exp2f(v * -1.4426950408889634f)); }
DI f32x4 sig4(const f32x4 v) { f32x4 o; o[0] = sig1(v[0]); o[1] = sig1(v[1]); o[2] = sig1(v[2]); o[3] = sig1(v[3]); return o; }
DI void up8(const u32x4 w, f32x4& a, f32x4& b) { a[0] = bf2f(w.x & 0xffffu); a[1] = bf2f(w.x >> 16); a[2] = bf2f(w.y & 0xffffu); a[3] = bf2f(w.y >> 16); b[0] = bf2f(w.z & 0xffffu); b[1] = bf2f(w.z >> 16); b[2] = bf2f(w.w & 0xffffu); b[3] = bf2f(w.w >> 16); }
#define EPI_ROWS(...) _Pragma("unroll") for (int ai = 0; ai < 2; ++ai) _Pragma("unroll") for (int m = 0; m < 4; ++m) { const int lr = ai * 128 + wr * 64 + m * 16 + fr; const int row = u.pm * 256 + lr; (void)row; __VA_ARGS__ }
struct EpiBf { static constexpr bool AFTER_DRAIN = false; bf16_t* O; int ld;
    DI void operator()(const f32x4 (&acc)[2][2][4][2], const Unit& u, int wr, int wc, int fr, int fq) const { asm volatile("" : "+v"(fr), "+v"(fq));
        const int c0 = u.pn * 256 + wc * 32 + 8 * fq;
        EPI_ROWS( bf16_t* rp = O + (size_t)row * ld + c0;
            _Pragma("unroll") for (int bj = 0; bj < 2; ++bj) *(u32x4*)(rp + bj * 128) = pack8(acc[ai][bj][m][0], acc[ai][bj][m][1]); )
    } };
DI unsigned pack4u8(const f32x4 v) { unsigned w = 0u;
    w = __builtin_amdgcn_cvt_pk_u8_f32(__builtin_rintf(v[0] * 255.f), 0u, w); w = __builtin_amdgcn_cvt_pk_u8_f32(__builtin_rintf(v[1] * 255.f), 1u, w);
    w = __builtin_amdgcn_cvt_pk_u8_f32(__builtin_rintf(v[2] * 255.f), 2u, w); w = __builtin_amdgcn_cvt_pk_u8_f32(__builtin_rintf(v[3] * 255.f), 3u, w); return w; }
DI f32x4 unpack4u8(const unsigned w) { return (f32x4){(float)(w & 255u), (float)((w >> 8) & 255u), (float)((w >> 16) & 255u), (float)(w >> 24)}; }
struct EpiProj { static constexpr bool AFTER_DRAIN = false; bf16_t* pa; unsigned char* pg;
    DI void operator()(const f32x4 (&acc)[2][2][4][2], const Unit& u, int wr, int wc, int fr, int fq) const { asm volatile("" : "+v"(fr), "+v"(fq));
        const int ct = u.pn * 256; const bool gate = ct >= PA; const int c0 = wc * 32 + 8 * fq;
        if (gate) {
            EPI_ROWS( unsigned char* rp = pg + (size_t)row * PG + (ct - PA) + c0;
                _Pragma("unroll") for (int bj = 0; bj < 2; ++bj) *(u32x2*)(rp + bj * 128) = (u32x2){pack4u8(sig4(acc[ai][bj][m][0])), pack4u8(sig4(acc[ai][bj][m][1]))}; )
        } else {
            EPI_ROWS( bf16_t* rp = pa + ct + (size_t)row * PA + c0;
                _Pragma("unroll") for (int bj = 0; bj < 2; ++bj) *(u32x4*)(rp + bj * 128) = pack8(acc[ai][bj][m][0], acc[ai][bj][m][1]); )
        }
    } };
struct EpiMerge { static constexpr bool AFTER_DRAIN = false; const unsigned char* pg; bf16_t* scr; bf16_t* mg;
    DI void operator()(const f32x4 (&acc)[2][2][4][2], const Unit& u, int wr, int wc, int fr, int fq) const { asm volatile("" : "+v"(fr), "+v"(fq));
        const int tid = (wr * 4 + wc) * 64 + fq * 16 + fr; bf16_t* my = scr + (size_t)blockIdx.x * 65536 + tid * 8;
        const int c0 = u.pn * 256 + wc * 32 + 8 * fq;
        if (u.s == 0) {
            EPI_ROWS( _Pragma("unroll") for (int bj = 0; bj < 2; ++bj)
                    *(u32x4*)(my + (size_t)((ai * 2 + bj) * 4 + m) * 4096) = pack8(acc[ai][bj][m][0], acc[ai][bj][m][1]); )
        } else {
            EPI_ROWS( _Pragma("unroll") for (int bj = 0; bj < 2; ++bj) {
                    const u32x2 ga = *(const u32x2*)(pg + (size_t)row * PG + c0 + bj * 128), gb = *(const u32x2*)(pg + (size_t)row * PG + 2048 + c0 + bj * 128);
                    const u32x4 tw = *(const u32x4*)(my + (size_t)((ai * 2 + bj) * 4 + m) * 4096);
                    f32x4 t0, t1; up8(tw, t0, t1);
                    const f32x4 a0 = unpack4u8(ga[0]), a1 = unpack4u8(ga[1]), b0 = unpack4u8(gb[0]), b1 = unpack4u8(gb[1]);
                    *(u32x4*)(mg + (size_t)row * D + c0 + bj * 128) = pack8((a0 * t0 + b0 * acc[ai][bj][m][0]) * (1.f / 255.f), (a1 * t1 + b1 * acc[ai][bj][m][1]) * (1.f / 255.f));
                    asm volatile("" ::: "memory"); } )
        }
    } };
template <bool XI_BF16> struct EpiRes { static constexpr bool AFTER_DRAIN = false; const void* xi; bf16_t* xb; float* part;
    DI void operator()(const f32x4 (&acc)[2][2][4][2], const Unit& u, int wr, int wc, int fr, int fq) const { asm volatile("" : "+v"(fr), "+v"(fq));
        const int c0 = u.pn * 256 + wc * 32 + 8 * fq;
        _Pragma("unroll") for (int ai = 0; ai < 2; ++ai) {
            f32x4 rr[4][2][2];
            _Pragma("unroll") for (int m = 0; m < 4; ++m) _Pragma("unroll") for (int bj = 0; bj < 2; ++bj) { const int row = u.pm * 256 + ai * 128 + wr * 64 + m * 16 + fr; const size_t off = (size_t)row * D + c0 + bj * 128;
                if constexpr (XI_BF16) { const u32x4 w = *(const u32x4*)((const bf16_t*)xi + off); rr[m][bj][0] = __builtin_bit_cast(f32x4, w); }
                else { rr[m][bj][0] = *(const f32x4*)((const float*)xi + off); rr[m][bj][1] = *(const f32x4*)((const float*)xi + off + 4); } }
            _Pragma("unroll") for (int m = 0; m < 4; ++m) { const int row = u.pm * 256 + ai * 128 + wr * 64 + m * 16 + fr; float ss = 0.f;
                _Pragma("unroll") for (int bj = 0; bj < 2; ++bj) { const size_t off = (size_t)row * D + c0 + bj * 128; f32x4 r0, r1;
                    if constexpr (XI_BF16) up8(__builtin_bit_cast(u32x4, rr[m][bj][0]), r0, r1); else { r0 = rr[m][bj][0]; r1 = rr[m][bj][1]; }
                    const f32x4 v0 = acc[ai][bj][m][0] + r0, v1 = acc[ai][bj][m][1] + r1;
                    *(u32x4*)(xb + off) = pack8(v0, v1);
                    ss += (v0[0] * v0[0] + v0[1] * v0[1]) + (v0[2] * v0[2] + v0[3] * v0[3]) + (v1[0] * v1[0] + v1[1] * v1[1]) + (v1[2] * v1[2] + v1[3] * v1[3]); }
                ss += __shfl_xor(ss, 16); ss += __shfl_xor(ss, 32);
                if (fq == 0) part[(size_t)row * 32 + u.pn * 4 + wc] = ss; }
            asm volatile("" ::: "memory"); }
    } };
struct EpiScore { static constexpr bool AFTER_DRAIN = false; bf16_t* S; const LAS float* rtab;
    DI void operator()(const f32x4 (&acc)[2][2][4][2], const Unit& u, int wr, int wc, int fr, int fq) const { asm volatile("" : "+v"(fr), "+v"(fq));
        const int c0 = u.pn * 256 + wc * 32 + 8 * fq;
        EPI_ROWS( const float r = rtab[u.idx * 256 + lr];
            _Pragma("unroll") for (int bj = 0; bj < 2; ++bj) *(u32x4*)(S + (size_t)row * D + c0 + bj * 128) = pack8(acc[ai][bj][m][0] * r, acc[ai][bj][m][1] * r); )
    } };
struct EpiSoftmax { static constexpr bool AFTER_DRAIN = true; bf16_t* P; const LAS float* rtab;
    DI void fused(f32x4 (&acc)[2][2][4][2], const Unit& u, int wr, int wc, int fr, int fq, LAS unsigned char* lds, int wid, int lane) const { asm volatile("" : "+v"(fr), "+v"(fq));
        LAS f32x2v* X = (LAS f32x2v*)lds;
        const float sc = 0.044194173824159216f * 1.4426950408889634f;
        EPI_ROWS( const float rs = rtab[lr] * sc; float mx = -3.0e38f;
            _Pragma("unroll") for (int bj = 0; bj < 2; ++bj) _Pragma("unroll") for (int n = 0; n < 2; ++n) { f32x4 v = acc[ai][bj][m][n] * rs; acc[ai][bj][m][n] = v; mx = fmaxf(mx, fmaxf(fmaxf(v[0], v[1]), fmaxf(v[2], v[3]))); }
            mx = fmaxf(mx, __shfl_xor(mx, 16)); mx = fmaxf(mx, __shfl_xor(mx, 32)); float sum = 0.f;
            _Pragma("unroll") for (int bj = 0; bj < 2; ++bj) _Pragma("unroll") for (int n = 0; n < 2; ++n) { f32x4 v = acc[ai][bj][m][n];
                v[0] = __builtin_amdgcn_exp2f(v[0] - mx); v[1] = __builtin_amdgcn_exp2f(v[1] - mx); v[2] = __builtin_amdgcn_exp2f(v[2] - mx); v[3] = __builtin_amdgcn_exp2f(v[3] - mx);
                acc[ai][bj][m][n] = v; sum += (v[0] + v[1]) + (v[2] + v[3]); }
            sum += __shfl_xor(sum, 16); sum += __shfl_xor(sum, 32);
            if (fq == 0) X[lr * 4 + wc] = (f32x2v){mx, sum}; )
        asm volatile("s_waitcnt lgkmcnt(0)" ::: "memory"); __builtin_amdgcn_s_barrier(); asm volatile("" ::: "memory");
        const int c0 = u.pn * 256 + wc * 32 + 8 * fq;
        EPI_ROWS( const f32x2v a = X[lr * 4 + 0], b = X[lr * 4 + 1], c = X[lr * 4 + 2], d = X[lr * 4 + 3];
            const float mt = fmaxf(fmaxf(a.x, b.x), fmaxf(c.x, d.x));
            const float lt = a.y * __builtin_amdgcn_exp2f(a.x - mt) + b.y * __builtin_amdgcn_exp2f(b.x - mt) + c.y * __builtin_amdgcn_exp2f(c.x - mt) + d.y * __builtin_amdgcn_exp2f(d.x - mt);
            const float own = (wc == 0) ? a.x : (wc == 1) ? b.x : (wc == 2) ? c.x : d.x;
            const float f = __builtin_amdgcn_exp2f(own - mt) * __builtin_amdgcn_rcpf(lt);
            bf16_t* rp = P + (size_t)row * 1024 + c0;
            _Pragma("unroll") for (int bj = 0; bj < 2; ++bj) *(u32x4*)(rp + bj * 128) = pack8(acc[ai][bj][m][0] * f, acc[ai][bj][m][1] * f); )
        asm volatile("s_waitcnt lgkmcnt(0)" ::: "memory"); __builtin_amdgcn_s_barrier();
    } };
}

struct Frame {
    LAS unsigned char* lds; unsigned char* ldsg;
    int tid, lane, wave, vcu, G, gw, NGW;
};
struct Args { const float* in[22]; float* out; unsigned char* ws; };
#define WB(off) ((bf16_t*)(args.ws + (off)))
#define WF(off) ((float*)(args.ws + (off)))

DI void p0_transpose_item(const float* W, int K, int N, bf16_t* WT, int row_off, float* scr, int item, int lane) {
    const int nblk = N / 32, kb = item / nblk, nb = item % nblk, k0 = 64 * kb, n0 = 32 * nb;
#pragma unroll 8
    for (int i = 0; i < 32; ++i) { const int kk = 2 * i + (lane >> 5); scr[kk * 33 + (lane & 31)] = W[(size_t)(k0 + kk) * N + n0 + (lane & 31)]; }
    asm volatile("s_waitcnt lgkmcnt(0)" ::: "memory");
    const int c = lane & 7;
#pragma unroll
    for (int j = 0; j < 4; ++j) { const int n = (lane >> 3) + 8 * j; const float* s = scr + (8 * c) * 33 + n;
        uint4 o; o.x = pk2(s[0 * 33], s[1 * 33]); o.y = pk2(s[2 * 33], s[3 * 33]); o.z = pk2(s[4 * 33], s[5 * 33]); o.w = pk2(s[6 * 33], s[7 * 33]);
        *(uint4*)(WT + (size_t)(row_off + n0 + n) * K + k0 + 8 * c) = o; }
    asm volatile("s_waitcnt lgkmcnt(0)" ::: "memory");
}
DI void convert_rows(Frame& F, const float* W, const float* g, bf16_t* O, int rows, int cols) {
    const size_t n8 = (size_t)rows * cols / 8;
    for (size_t i = (size_t)F.vcu * NTHR + F.tid; i < n8; i += (size_t)F.G * NTHR) {
        const size_t e = i * 8; const float s = g ? g[(int)(e / cols)] : 1.f;
        const float4 a = *(const float4*)(W + e), b = *(const float4*)(W + e + 4);
        uint4 o; o.x = pk2(a.x * s, a.y * s); o.y = pk2(a.z * s, a.w * s); o.z = pk2(b.x * s, b.y * s); o.w = pk2(b.z * s, b.w * s);
        *(uint4*)(O + e) = o;
    }
}
DI void rmsnorm_rows(Frame& F, const float* X, const float* g, bf16_t* O, int rows) {
    for (int row = F.gw; row < rows; row += F.NGW) {
        const float4* xr = (const float4*)(X + (size_t)row * D) + F.lane;
        float4 v[8]; float s = 0.f;
#pragma unroll
        for (int j = 0; j < 8; ++j) { v[j] = xr[64 * j]; s += v[j].x * v[j].x + v[j].y * v[j].y + v[j].z * v[j].z + v[j].w * v[j].w; }
        const float r = rsqrtf(wave_sum(s) * (1.f / D) + EPS);
        uint2* o = (uint2*)(O + (size_t)row * D) + F.lane;
#pragma unroll
        for (int j = 0; j < 8; ++j) { const float4 gg = ((const float4*)g)[F.lane + 64 * j];
            uint2 w; w.x = pk2(v[j].x * r * gg.x, v[j].y * r * gg.y); w.y = pk2(v[j].z * r * gg.z, v[j].w * r * gg.w); o[64 * j] = w; }
    }
}
constexpr int P0_I_IN = 32 * 320, P0_I_AT = 16 * 64, P0_I_SQ = 32 * 64;
DI void p0_deferred(Frame& F, const Args& args, int hw, int HW) {
    float* scr = (float*)(F.ldsg + F.wave * 16384);
    constexpr int I_AT = P0_I_AT, I_SQ = P0_I_SQ;
    for (int it = hw; it < 2 * I_AT + 2 * I_SQ; it += HW) {
        int r = it;
        if (r < I_AT) { p0_transpose_item(args.in[7], 1024, 2048, WB(WS_WATT), 0, scr, r, F.lane); continue; } r -= I_AT;
        if (r < I_AT) { p0_transpose_item(args.in[8], 1024, 2048, WB(WS_WCONV), 0, scr, r, F.lane); continue; } r -= I_AT;
        if (r < I_SQ) { p0_transpose_item(args.in[9], 2048, 2048, WB(WS_WMIX), 0, scr, r, F.lane); continue; } r -= I_SQ;
        p0_transpose_item(args.in[15], 2048, 2048, WB(WS_WCOT), 0, scr, r, F.lane);
    }
    { const float* W = args.in[12]; const float* g = args.in[10]; bf16_t* O = WB(WS_WCQN);
      for (size_t i = (size_t)hw * 64 + F.lane; i < (size_t)2048 * 2048 / 8; i += (size_t)HW * 64) {
          const size_t e = i * 8; const float sg = g[(int)(e / 2048)];
          const float4 a = *(const float4*)(W + e), b = *(const float4*)(W + e + 4);
          uint4 o; o.x = pk2(a.x * sg, a.y * sg); o.y = pk2(a.z * sg, a.w * sg); o.z = pk2(b.x * sg, b.y * sg); o.w = pk2(b.z * sg, b.w * sg);
          *(uint4*)(O + e) = o; } }
}
DI void p0_prologue(Frame& F, const Args& args) {
    float* scr = (float*)(F.ldsg + F.wave * 16384);
    constexpr int I_IN = P0_I_IN, I_SQ = P0_I_SQ;
    for (int it = F.gw; it < I_IN + 2 * I_SQ; it += F.NGW) {
        int r = it;
        if (r < I_IN) { p0_transpose_item(args.in[3], 2048, INC, WB(WS_WINT), 0, scr, r, F.lane); continue; } r -= I_IN;
        if (r < I_SQ) { p0_transpose_item(args.in[13], 2048, 2048, WB(WS_WKVT), 0, scr, r, F.lane); continue; } r -= I_SQ;
        p0_transpose_item(args.in[14], 2048, 2048, WB(WS_WKVT), 2048, scr, r, F.lane);
    }
    convert_rows(F, args.in[17], args.in[16], WB(WS_WPQN), 2048, 2048);
    for (int i = F.vcu * NTHR + F.tid; i < 2048 * 32; i += F.G * NTHR) {
        const int r = i >> 5, c8 = (i & 31) * 8, g = r >> 7; uint4 o = make_uint4(0u, 0u, 0u, 0u);
        if ((c8 >> 7) == (g & 1)) { const float* sp = args.in[18] + (size_t)r * 128 + (c8 & 127); const float4 a = *(const float4*)sp, b = *(const float4*)(sp + 4);
            o.x = pk2(a.x, a.y); o.y = pk2(a.z, a.w); o.z = pk2(b.x, b.y); o.w = pk2(b.z, b.w); }
        *(uint4*)(WB(WS_AKEYS) + (size_t)r * 256 + c8) = o;
    }
    rmsnorm_rows(F, args.in[0], args.in[2], WB(WS_H1), M);
    rmsnorm_rows(F, args.in[1], args.in[11], WB(WS_MEMN), MROWS);
}

typedef float f32x16 __attribute__((ext_vector_type(16)));
typedef short v4i16_t __attribute__((ext_vector_type(4)));
constexpr int BA_KROW = 272, BA_VROW = 320, BA_KSZ = 64 * BA_KROW, BA_BUF = BA_KSZ + 64 * BA_VROW, BA_TAB = 2 * BA_BUF;
DI int crow(int r, int hi) { return (r & 3) + 8 * (r >> 2) + 4 * hi; }
DI unsigned cvtpk(float lo, float hi) { unsigned r; asm volatile("v_cvt_pk_bf16_f32 %0, %1, %2" : "=v"(r) : "v"(lo), "v"(hi)); return r; }
DI bf16x8 pack_frag(const f32x16& p, int b) { u32x4 w; w.x = cvtpk(p[b], p[b + 1]); w.y = cvtpk(p[b + 2], p[b + 3]); w.z = cvtpk(p[b + 4], p[b + 5]); w.w = cvtpk(p[b + 6], p[b + 7]); return __builtin_bit_cast(bf16x8, w); }
DI void battn_unit(LAS unsigned char* lds, const bf16_t* __restrict__ pa, const float* __restrict__ relb, bf16_t* __restrict__ oatt, int unit) {
    int tid = threadIdx.x; asm volatile("" : "+v"(tid)); const int lane = tid & 63, wave = __builtin_amdgcn_readfirstlane(tid >> 6);
    const int cg = unit & 15, h = (unit >> 4) & 7, b = unit >> 7;
    const int c = cg * 4 + (wave >> 1), r32 = lane & 31, hi = lane >> 5, a = 32 * (wave & 1) + r32;
    const int tok = b * SEQ + c * 64 + a;
    const float LOG2E = 1.4426950408889634f, SC = 0.08838834764831845f * LOG2E;
    LAS float* tab = (LAS float*)(lds + BA_TAB);
    for (int i = tid; i < 257; i += NTHR) tab[i] = relb[h * 257 + i] * LOG2E;
    bf16x8 qf[8];
    { const bf16_t* qp = pa + (size_t)tok * PA + h * 128 + 8 * hi;
#pragma unroll
      for (int ks = 0; ks < 8; ++ks) qf[ks] = *(const bf16x8*)(qp + ks * 16); }
    f32x16 o0 = {}, o1 = {}, o2 = {}, o3 = {};
    float m = -1.0e30f, l = 0.f;
    const int src0 = cg * 4 - 8, first = src0 < 0 ? -src0 : 0;
    u32x4 kr0, kr1, vr0, vr1;
    const int key0 = tid >> 4, part = tid & 15;
    const bf16_t* gbase = pa + (size_t)(b * SEQ + key0) * PA + h * 128 + part * 8;
#define BA_GLOAD(src) do { const bf16_t* rp_ = gbase + (size_t)(src) * 64 * PA; kr0 = *(const u32x4*)(rp_ + 1024); vr0 = *(const u32x4*)(rp_ + 2048); \
        kr1 = *(const u32x4*)(rp_ + (size_t)32 * PA + 1024); vr1 = *(const u32x4*)(rp_ + (size_t)32 * PA + 2048); } while (0)
    BA_GLOAD(src0 + first);
    int buf = 0;
    const int vlane = (4 * hi + ((lane & 15) >> 2)) * BA_VROW + (16 * ((lane >> 4) & 1) + 4 * (lane & 3)) * 2;
    for (int kt = first; kt < 12; ++kt) {
        const int src = src0 + kt;
        LAS unsigned char* Kb = lds + buf * BA_BUF; LAS unsigned char* Vb = Kb + BA_KSZ;
        *(LAS u32x4*)(Kb + key0 * BA_KROW + part * 16) = kr0; *(LAS u32x4*)(Kb + (key0 + 32) * BA_KROW + part * 16) = kr1;
        *(LAS u32x4*)(Vb + key0 * BA_VROW + part * 16) = vr0; *(LAS u32x4*)(Vb + (key0 + 32) * BA_VROW + part * 16) = vr1;
        if (kt + 1 < 12) BA_GLOAD(src + 1);
        __syncthreads();
        const int dc = c - src;
        if (dc >= 0 && dc <= 8) {
            f32x16 p0 = {}, p1 = {};
            const LAS unsigned char* kp = Kb + r32 * BA_KROW + hi * 16;
#pragma unroll
            for (int ks = 0; ks < 8; ++ks) {
                const bf16x8 k0 = *(const LAS bf16x8*)(kp + ks * 32), k1 = *(const LAS bf16x8*)(kp + 32 * BA_KROW + ks * 32);
                p0 = __builtin_amdgcn_mfma_f32_32x32x16_bf16(k0, qf[ks], p0, 0, 0, 0);
                p1 = __builtin_amdgcn_mfma_f32_32x32x16_bf16(k1, qf[ks], p1, 0, 0, 0);
            }
            if (dc >= 3) { const float bc = tab[256];
#pragma unroll
                for (int r = 0; r < 16; ++r) { p0[r] = p0[r] * SC + bc; p1[r] = p1[r] * SC + bc; }
            } else { const int rb = dc * 64 + a + 128;
#pragma unroll
                for (int r = 0; r < 16; ++r) { const int i0 = rb - crow(r, hi), i1 = i0 - 32;
                    p0[r] = p0[r] * SC + tab[i0 > 256 ? 256 : i0]; p1[r] = p1[r] * SC + tab[i1 > 256 ? 256 : i1]; }
            }
            float mx = fmaxf(p0[0], p1[0]);
#pragma unroll
            for (int r = 1; r < 16; ++r) mx = fmaxf(mx, fmaxf(p0[r], p1[r]));
            mx = fmaxf(mx, __shfl_xor(mx, 32));
            const float mn = fmaxf(m, mx), alpha = __builtin_amdgcn_exp2f(m - mn); m = mn;
            float ls = 0.f;
#pragma unroll
            for (int r = 0; r < 16; ++r) { p0[r] = __builtin_amdgcn_exp2f(p0[r] - mn); p1[r] = __builtin_amdgcn_exp2f(p1[r] - mn); ls += p0[r] + p1[r]; }
            l = l * alpha + ls;
            o0 *= alpha; o1 *= alpha; o2 *= alpha; o3 *= alpha;
            bf16x8 pf[4]; pf[0] = pack_frag(p0, 0); pf[1] = pack_frag(p0, 8); pf[2] = pack_frag(p1, 0); pf[3] = pack_frag(p1, 8);
            const LAS unsigned char* vl = Vb + vlane;
#pragma unroll
            for (int s4 = 0; s4 < 4; ++s4) {
#define BA_VF(db) ({ const v4i16_t lo_ = __builtin_amdgcn_ds_read_tr16_b64_v4i16((LAS v4i16_t*)(vl + s4 * 16 * BA_VROW + (db) * 64)); \
                     const v4i16_t hi_ = __builtin_amdgcn_ds_read_tr16_b64_v4i16((LAS v4i16_t*)(vl + s4 * 16 * BA_VROW + 8 * BA_VROW + (db) * 64)); \
                     (bf16x8){lo_[0], lo_[1], lo_[2], lo_[3], hi_[0], hi_[1], hi_[2], hi_[3]}; })
                o0 = __builtin_amdgcn_mfma_f32_32x32x16_bf16(BA_VF(0), pf[s4], o0, 0, 0, 0);
                o1 = __builtin_amdgcn_mfma_f32_32x32x16_bf16(BA_VF(1), pf[s4], o1, 0, 0, 0);
                o2 = __builtin_amdgcn_mfma_f32_32x32x16_bf16(BA_VF(2), pf[s4], o2, 0, 0, 0);
                o3 = __builtin_amdgcn_mfma_f32_32x32x16_bf16(BA_VF(3), pf[s4], o3, 0, 0, 0);
#undef BA_VF
            }
        }
        buf ^= 1;
    }
#undef BA_GLOAD
    const float inv = __builtin_amdgcn_rcpf(l + __shfl_xor(l, 32));
    bf16_t* op = oatt + (size_t)tok * 1024 + h * 128 + 4 * hi;
#define BA_ST(o, db) do { _Pragma("unroll") for (int rg = 0; rg < 4; ++rg) { uint2 w_; w_.x = cvtpk(o[4 * rg] * inv, o[4 * rg + 1] * inv); w_.y = cvtpk(o[4 * rg + 2] * inv, o[4 * rg + 3] * inv); \
        *(uint2*)(op + (db) * 32 + 8 * rg) = w_; } } while (0)
    BA_ST(o0, 0); BA_ST(o1, 1); BA_ST(o2, 2); BA_ST(o3, 3);
#undef BA_ST
    __syncthreads();
}
DI void ld8bf(const bf16_t* p, float* o) { unpack8(*(const uint4*)p, o); }
DI void conv_item(const bf16_t* __restrict__ pa, const float* __restrict__ cw, const float* __restrict__ cb, bf16_t* __restrict__ yc, int gid) {
    const int cg = gid & 127, tb = gid >> 7, c0 = cg * 8, t0 = tb * 16;
    float w0[8], w1[8], w2[8], bb[8], m1[8], m2[8];
#pragma unroll
    for (int j = 0; j < 8; ++j) { w0[j] = cw[c0 + j]; w1[j] = cw[1024 + c0 + j]; w2[j] = cw[2048 + c0 + j]; bb[j] = cb[c0 + j]; m1[j] = 0.f; m2[j] = 0.f; }
    if ((t0 & (SEQ - 1)) != 0) {
        float u[8], c[8];
        ld8bf(pa + (size_t)(t0 - 2) * PA + 3072 + c0, u); ld8bf(pa + (size_t)(t0 - 2) * PA + 5120 + c0, c);
#pragma unroll
        for (int j = 0; j < 8; ++j) m2[j] = u[j] * c[j];
        ld8bf(pa + (size_t)(t0 - 1) * PA + 3072 + c0, u); ld8bf(pa + (size_t)(t0 - 1) * PA + 5120 + c0, c);
#pragma unroll
        for (int j = 0; j < 8; ++j) m1[j] = u[j] * c[j];
    }
#pragma unroll 1
    for (int tq = t0; tq < t0 + 16; tq += 8) {
        uint4 ur[8], cr[8], gr[8];
#pragma unroll
        for (int q = 0; q < 8; ++q) { const bf16_t* rp = pa + (size_t)(tq + q) * PA + c0; ur[q] = *(const uint4*)(rp + 3072); cr[q] = *(const uint4*)(rp + 5120); gr[q] = *(const uint4*)(rp + 4096); }
#pragma unroll
        for (int q = 0; q < 8; ++q) { float u[8], c[8], g[8], y[8]; unpack8(ur[q], u); unpack8(cr[q], c); unpack8(gr[q], g);
#pragma unroll
            for (int j = 0; j < 8; ++j) { const float cu = u[j] * c[j]; y[j] = g[j] * (bb[j] + w0[j] * m2[j] + w1[j] * m1[j] + w2[j] * cu); m2[j] = m1[j]; m1[j] = cu; }
            uint4 o; o.x = pk2(y[0], y[1]); o.y = pk2(y[2], y[3]); o.z = pk2(y[4], y[5]); o.w = pk2(y[6], y[7]);
            *(uint4*)(yc + (size_t)(tq + q) * 1024 + c0) = o; }
    }
}

DI unsigned f2key(float f) { const unsigned u = __float_as_uint(f); return u ^ ((unsigned)((int)u >> 31) | 0x80000000u); }
DI float key2f(unsigned s) { return __uint_as_float(s ^ ((unsigned)((int)(~s) >> 31) | 0x80000000u)); }
#define INS16(T, key) do { unsigned v_ = (key); _Pragma("unroll") for (int q_ = 0; q_ < 16; ++q_) { const unsigned t_ = T[q_] > v_ ? T[q_] : v_; v_ = T[q_] > v_ ? v_ : T[q_]; T[q_] = t_; } } while (0)
#define CE_(x, y) do { const unsigned hi_ = (x) > (y) ? (x) : (y), lo_ = (x) > (y) ? (y) : (x); (x) = hi_; (y) = lo_; } while (0)
#define BSORT16(A) do { CE_(A[0], A[1]); CE_(A[3], A[2]); CE_(A[4], A[5]); CE_(A[7], A[6]); CE_(A[8], A[9]); CE_(A[11], A[10]); CE_(A[12], A[13]); CE_(A[15], A[14]); CE_(A[0], A[2]); CE_(A[1], A[3]); CE_(A[6], A[4]); CE_(A[7], A[5]); CE_(A[8], A[10]); CE_(A[9], A[11]); CE_(A[14], A[12]); CE_(A[15], A[13]); CE_(A[0], A[1]); CE_(A[2], A[3]); CE_(A[5], A[4]); CE_(A[7], A[6]); CE_(A[8], A[9]); CE_(A[10], A[11]); CE_(A[13], A[12]); CE_(A[15], A[14]); CE_(A[0], A[4]); CE_(A[1], A[5]); CE_(A[2], A[6]); CE_(A[3], A[7]); CE_(A[12], A[8]); CE_(A[13], A[9]); CE_(A[14], A[10]); CE_(A[15], A[11]); CE_(A[0], A[2]); CE_(A[1], A[3]); CE_(A[4], A[6]); CE_(A[5], A[7]); CE_(A[10], A[8]); CE_(A[11], A[9]); CE_(A[14], A[12]); CE_(A[15], A[13]); CE_(A[0], A[1]); CE_(A[2], A[3]); CE_(A[4], A[5]); CE_(A[6], A[7]); CE_(A[9], A[8]); CE_(A[11], A[10]); CE_(A[13], A[12]); CE_(A[15], A[14]); CE_(A[0], A[8]); CE_(A[1], A[9]); CE_(A[2], A[10]); CE_(A[3], A[11]); CE_(A[4], A[12]); CE_(A[5], A[13]); CE_(A[6], A[14]); CE_(A[7], A[15]); CE_(A[0], A[4]); CE_(A[1], A[5]); CE_(A[2], A[6]); CE_(A[3], A[7]); CE_(A[8], A[12]); CE_(A[9], A[13]); CE_(A[10], A[14]); CE_(A[11], A[15]); CE_(A[0], A[2]); CE_(A[1], A[3]); CE_(A[4], A[6]); CE_(A[5], A[7]); CE_(A[8], A[10]); CE_(A[9], A[11]); CE_(A[12], A[14]); CE_(A[13], A[15]); CE_(A[0], A[1]); CE_(A[2], A[3]); CE_(A[4], A[5]); CE_(A[6], A[7]); CE_(A[8], A[9]); CE_(A[10], A[11]); CE_(A[12], A[13]); CE_(A[14], A[15]); } while (0)
#define BMERGE16(A) do { CE_(A[0], A[8]); CE_(A[1], A[9]); CE_(A[2], A[10]); CE_(A[3], A[11]); CE_(A[4], A[12]); CE_(A[5], A[13]); CE_(A[6], A[14]); CE_(A[7], A[15]); CE_(A[0], A[4]); CE_(A[1], A[5]); CE_(A[2], A[6]); CE_(A[3], A[7]); CE_(A[8], A[12]); CE_(A[9], A[13]); CE_(A[10], A[14]); CE_(A[11], A[15]); CE_(A[0], A[2]); CE_(A[1], A[3]); CE_(A[4], A[6]); CE_(A[5], A[7]); CE_(A[8], A[10]); CE_(A[9], A[11]); CE_(A[12], A[14]); CE_(A[13], A[15]); CE_(A[0], A[1]); CE_(A[2], A[3]); CE_(A[4], A[5]); CE_(A[6], A[7]); CE_(A[8], A[9]); CE_(A[10], A[11]); CE_(A[12], A[13]); CE_(A[14], A[15]); } while (0)
#define TOPMERGE16(T, B) do { _Pragma("unroll") for (int q_ = 0; q_ < 16; ++q_) T[q_] = T[q_] > B[15 - q_] ? T[q_] : B[15 - q_]; BMERGE16(T); } while (0)
DI void topk_item4(const bf16_t* __restrict__ scores, int* __restrict__ idx, float* __restrict__ gate, int item, LAS unsigned char* wl, int lane) {
    const bf16_t* sp = scores + (size_t)item * 4 * D;
    unsigned top[16];
#pragma unroll 1
    for (int h = 0; h < 2; ++h) {
#pragma unroll
        for (int i = 0; i < 8; ++i) { const int grp = i * 8 + (lane >> 3), piece = lane & 7;
            const u32x4 w = *(const u32x4*)(sp + grp * 128 + h * 64 + piece * 8); f32x4 va, vb; pg8::up8(w, va, vb);
            *(LAS f32x4*)(wl + grp * 272 + piece * 32) = va; *(LAS f32x4*)(wl + grp * 272 + piece * 32 + 16) = vb; }
        asm volatile("s_waitcnt vmcnt(0) lgkmcnt(0)" ::: "memory");
#pragma unroll
        for (int bk = 0; bk < 4; ++bk) {
            unsigned blk[16];
#pragma unroll
            for (int j = 0; j < 4; ++j) { const f32x4 v = *(const LAS f32x4*)(wl + lane * 272 + (bk * 4 + j) * 16);
#pragma unroll
                for (int e = 0; e < 4; ++e) blk[j * 4 + e] = (f2key(v[e]) & ~127u) | (unsigned)(h * 64 + bk * 16 + j * 4 + e); }
            BSORT16(blk);
            if (h == 0 && bk == 0) {
#pragma unroll
                for (int q = 0; q < 16; ++q) top[q] = blk[q];
            } else TOPMERGE16(top, blk);
        }
        asm volatile("s_waitcnt lgkmcnt(0)" ::: "memory");
    }
    const int p = lane & 1;
    unsigned L1[16], L2[16]; float v1[16], v2[16];
#pragma unroll
    for (int i = 0; i < 16; ++i) { const unsigned pt = __shfl_xor(top[i], 1); L1[i] = p ? pt : top[i]; L2[i] = p ? top[i] : pt; v1[i] = key2f(L1[i] & ~127u); v2[i] = key2f(L2[i] & ~127u); }
    unsigned cd[64];
    { int n = 0;
#pragma unroll
      for (int i = 0; i < 16; ++i)
#pragma unroll
        for (int j = 0; j < 16; ++j) if ((i + 1) * (j + 1) <= 16) { cd[n] = (f2key(v1[i] + v2[j]) & ~255u) | (unsigned)(i * 16 + j); ++n; }
#pragma unroll
      for (int q = 50; q < 64; ++q) cd[q] = 0u; }
    unsigned ct[16];
#pragma unroll
    for (int bk = 0; bk < 4; ++bk) { unsigned blk[16];
#pragma unroll
        for (int q = 0; q < 16; ++q) blk[q] = cd[bk * 16 + q];
        BSORT16(blk);
        if (bk == 0) {
#pragma unroll
            for (int q = 0; q < 16; ++q) ct[q] = blk[q];
        } else TOPMERGE16(ct, blk); }
    const float mx = key2f(ct[0] & ~255u); float sum = 0.f;
#pragma unroll
    for (int t = 0; t < 16; ++t) sum += __expf(key2f(ct[t] & ~255u) - mx);
    const float isum = __builtin_amdgcn_rcpf(sum);
    const int tl = lane >> 4, head = (lane & 15) >> 1;
    const size_t ob = (size_t)(item * 4 + tl) * 128 + head * 16 + p * 8;
    { u32x4 w1, w2;
#define PK4(L, b) ((L[b] & 127u) | ((L[b + 1] & 127u) << 8) | ((L[b + 2] & 127u) << 16) | ((L[b + 3] & 127u) << 24))
      w1.x = PK4(L1, 0); w1.y = PK4(L1, 4); w1.z = PK4(L1, 8); w1.w = PK4(L1, 12); w2.x = PK4(L2, 0); w2.y = PK4(L2, 4); w2.z = PK4(L2, 8); w2.w = PK4(L2, 12);
#undef PK4
      *(LAS u32x4*)(wl + lane * 272) = w1; *(LAS u32x4*)(wl + lane * 272 + 16) = w2; }
    asm volatile("s_waitcnt lgkmcnt(0)" ::: "memory");
    int ev[8]; float gv[8];
#pragma unroll
    for (int t = 0; t < 8; ++t) { const unsigned ck = ct[t] ^ ((ct[t] ^ ct[8 + t]) & (0u - (unsigned)p));
        const unsigned i1 = *(const LAS unsigned char*)(wl + lane * 272 + ((ck >> 4) & 15u)), i2 = *(const LAS unsigned char*)(wl + lane * 272 + 16 + (ck & 15u));
        ev[t] = (int)(i1 * 128u + i2);
        gv[t] = __expf(key2f(ck & ~255u) - mx) * isum; }
    asm volatile("s_waitcnt lgkmcnt(0)" ::: "memory");
    *(int4*)(idx + ob) = make_int4(ev[0], ev[1], ev[2], ev[3]); *(int4*)(idx + ob + 4) = make_int4(ev[4], ev[5], ev[6], ev[7]);
    *(float4*)(gate + ob) = make_float4(gv[0], gv[1], gv[2], gv[3]); *(float4*)(gate + ob + 4) = make_float4(gv[4], gv[5], gv[6], gv[7]);
}

typedef float v2f __attribute__((ext_vector_type(2)));
DI float gelu_exact(float x) { return 0.5f * x * (1.f + erff(x * 0.70710678118654752f)); }
typedef unsigned u32x6 __attribute__((ext_vector_type(6)));
typedef float f32x32 __attribute__((ext_vector_type(32)));
constexpr int FP6_ROW = 1536;
DI unsigned fp6_code(float x) {
    const float a = fminf(fabsf(x), 7.5f);
    unsigned c = a < 1.f ? (unsigned)__builtin_rintf(a * 8.f) : ((__float_as_uint(a) + 0x80000u) >> 20) - 1008u;
    c = c > 31u ? 31u : c;
    return c | ((__float_as_uint(x) >> 26) & 32u);
}
typedef float f32x16 __attribute__((ext_vector_type(16)));
DI void fp6_encode_row(const f32x4 (&v)[8], float mx, unsigned char* __restrict__ dst, float* __restrict__ inv, int row, int lane) {
    int k = 2 - ((int)((__float_as_uint(mx) >> 23) & 255u) - 127); k = k > 100 ? 100 : (k < -100 ? -100 : k);
    const float sc = __uint_as_float((unsigned)(127 + k) << 23), isc = __uint_as_float((unsigned)(127 - k) << 23);
    f32x16 a, b;
#pragma unroll
    for (int i = 0; i < 16; ++i) { a[i] = v[(2 * i) >> 2][(2 * i) & 3] * sc; b[i] = v[(2 * i + 1) >> 2][(2 * i + 1) & 3] * sc; }
    const u32x6 w = __builtin_amdgcn_cvt_scalef32_2xpk16_fp6_f32(a, b, 1.0f);
    unsigned char* op = dst + ((size_t)(lane >> 3) * NEXP + row) * 192 + (lane & 7) * 24;
    *(u32x2*)op = (u32x2){w[0], w[1]}; *(u32x2*)(op + 8) = (u32x2){w[2], w[3]}; *(u32x2*)(op + 16) = (u32x2){w[4], w[5]};
    if (lane == 0) inv[2 * row] = isc;
}
template <bool GAIN = false>
DI void convert_fp6_rows(Frame& F, const float* __restrict__ src, unsigned char* __restrict__ dst, float* __restrict__ inv, int rows, int wv, int nw, LAS unsigned char* wl, const float* __restrict__ gain = nullptr) {
    if (wv >= rows) return;
    f32x4 v[8];
    { const float* rp = src + (size_t)wv * D + F.lane * 4;
#pragma unroll
      for (int q = 0; q < 8; ++q) v[q] = *(const f32x4*)(rp + q * 256); }
    for (int row = wv; row < rows; row += nw) {
        float mx = 0.f;
#pragma unroll
        for (int q = 0; q < 8; ++q) { f32x4 t = v[q]; if (GAIN) t = t * *(const f32x4*)(gain + F.lane * 4 + q * 256);
            mx = fmaxf(mx, fmaxf(fmaxf(fabsf(t[0]), fabsf(t[1])), fmaxf(fabsf(t[2]), fabsf(t[3]))));
            const int c = (q * 64 + F.lane) * 4; *(LAS f32x4*)(wl + (c + 4 * (c >> 5)) * 4) = t; }
        { const int nr = row + nw < rows ? row + nw : row; const float* rp = src + (size_t)nr * D + F.lane * 4;
#pragma unroll
          for (int q = 0; q < 8; ++q) v[q] = *(const f32x4*)(rp + q * 256); }
        mx = wave_max(mx);
        asm volatile("s_waitcnt lgkmcnt(0)" ::: "memory");
        f32x4 r[8];
#pragma unroll
        for (int i = 0; i < 8; ++i) r[i] = *(const LAS f32x4*)(wl + (36 * F.lane + 4 * i) * 4);
        asm volatile("s_waitcnt lgkmcnt(0)" ::: "memory");
        fp6_encode_row(r, mx, dst, inv, row, F.lane);
    }
}
constexpr int FP4_SLICE = 128;
DI unsigned fp4_code(float x) {
    const float a = fabsf(x);
    unsigned c = a < 1.f ? (unsigned)__builtin_rintf(a * 2.f) : ((__float_as_uint(a) + 0x200000u) >> 22) - 252u;
    c = c > 7u ? 7u : c;
    return c | ((__float_as_uint(x) >> 28) & 8u);
}
template <bool GAIN>
DI void convert_fp4_rows(Frame& F, const float* __restrict__ src, unsigned char* __restrict__ dst, float* __restrict__ inv, int rows, int wv, int nw, LAS unsigned char* wl, const float* __restrict__ gain) {
    if (wv >= rows) return;
    f32x4 v[8];
    { const float* rp = src + (size_t)wv * D + F.lane * 4;
#pragma unroll
      for (int q = 0; q < 8; ++q) v[q] = *(const f32x4*)(rp + q * 256); }
    for (int row = wv; row < rows; row += nw) {
        float mx = 0.f;
#pragma unroll
        for (int q = 0; q < 8; ++q) { f32x4 t = v[q]; if (GAIN) t = t * *(const f32x4*)(gain + F.lane * 4 + q * 256);
            mx = fmaxf(mx, fmaxf(fmaxf(fabsf(t[0]), fabsf(t[1])), fmaxf(fabsf(t[2]), fabsf(t[3]))));
            const int c = (q * 64 + F.lane) * 4; *(LAS f32x4*)(wl + (c + 4 * (c >> 5)) * 4) = t; }
        { const int nr = row + nw < rows ? row + nw : row; const float* rp = src + (size_t)nr * D + F.lane * 4;
#pragma unroll
          for (int q = 0; q < 8; ++q) v[q] = *(const f32x4*)(rp + q * 256); }
        mx = wave_max(mx);
        asm volatile("s_waitcnt lgkmcnt(0)" ::: "memory");
        f32x4 r[8];
#pragma unroll
        for (int i = 0; i < 8; ++i) r[i] = *(const LAS f32x4*)(wl + (36 * F.lane + 4 * i) * 4);
        asm volatile("s_waitcnt lgkmcnt(0)" ::: "memory");
        const unsigned mu = __float_as_uint(mx);
        int k = ((mu & 0x7fffffu) > 0x400000u ? 1 : 2) - ((int)((mu >> 23) & 255u) - 127); k = k > 100 ? 100 : (k < -100 ? -100 : k);
        const float sc = __uint_as_float((unsigned)(127 + k) << 23), isc = __uint_as_float((unsigned)(127 - k) << 23);
        unsigned w[4];
#pragma unroll
        for (int d = 0; d < 4; ++d) { unsigned acc = 0u;
#pragma unroll
            for (int b = 0; b < 4; ++b) { const float v0_ = r[(d * 8 + 2 * b) >> 2][(d * 8 + 2 * b) & 3] * sc, v1_ = r[(d * 8 + 2 * b + 1) >> 2][(d * 8 + 2 * b + 1) & 3] * sc;
                acc = b == 0 ? __builtin_amdgcn_cvt_scalef32_pk_fp4_f32(acc, v0_, v1_, 1.0f, 0) : b == 1 ? __builtin_amdgcn_cvt_scalef32_pk_fp4_f32(acc, v0_, v1_, 1.0f, 1)
                    : b == 2 ? __builtin_amdgcn_cvt_scalef32_pk_fp4_f32(acc, v0_, v1_, 1.0f, 2) : __builtin_amdgcn_cvt_scalef32_pk_fp4_f32(acc, v0_, v1_, 1.0f, 3); }
            w[d] = acc; }
        *(u32x4*)(dst + ((size_t)(F.lane >> 3) * NEXP + row) * FP4_SLICE + (F.lane & 7) * 16) = (u32x4){w[0], w[1], w[2], w[3]};
        if (F.lane == 0) inv[2 * row] = isc;
    }
}
template <int FMT>
DI float convert_row_a(Frame& F, const f32x4 (&v)[8], LAS unsigned char* wl, const float* __restrict__ gain) {
    float mx = 0.f;
#pragma unroll
    for (int q = 0; q < 8; ++q) { f32x4 t = v[q]; if (FMT == 4 && gain) t = t * *(const f32x4*)(gain + F.lane * 4 + q * 256);
        mx = fmaxf(mx, fmaxf(fmaxf(fabsf(t[0]), fabsf(t[1])), fmaxf(fabsf(t[2]), fabsf(t[3]))));
        const int c = (q * 64 + F.lane) * 4; *(LAS f32x4*)(wl + (c + 4 * (c >> 5)) * 4) = t; }
    return mx;
}
template <int FMT>
DI void convert_row_b(Frame& F, float mx, unsigned char* __restrict__ dst, float* __restrict__ inv, int row, LAS unsigned char* wl) {
    mx = wave_max(mx);
    asm volatile("s_waitcnt lgkmcnt(0)" ::: "memory");
    f32x4 r[8];
#pragma unroll
    for (int i = 0; i < 8; ++i) r[i] = *(const LAS f32x4*)(wl + (36 * F.lane + 4 * i) * 4);
    asm volatile("s_waitcnt lgkmcnt(0)" ::: "memory");
    if (FMT == 6) { fp6_encode_row(r, mx, dst, inv, row, F.lane); return; }
    const unsigned mu = __float_as_uint(mx);
    int k = ((mu & 0x7fffffu) > 0x400000u ? 1 : 2) - ((int)((mu >> 23) & 255u) - 127); k = k > 100 ? 100 : (k < -100 ? -100 : k);
    const float sc = __uint_as_float((unsigned)(127 + k) << 23), isc = __uint_as_float((unsigned)(127 - k) << 23);
    unsigned w[4];
#pragma unroll
    for (int d = 0; d < 4; ++d) { unsigned acc = 0u;
#pragma unroll
        for (int b = 0; b < 4; ++b) { const float v0_ = r[(d * 8 + 2 * b) >> 2][(d * 8 + 2 * b) & 3] * sc, v1_ = r[(d * 8 + 2 * b + 1) >> 2][(d * 8 + 2 * b + 1) & 3] * sc;
            acc = b == 0 ? __builtin_amdgcn_cvt_scalef32_pk_fp4_f32(acc, v0_, v1_, 1.0f, 0) : b == 1 ? __builtin_amdgcn_cvt_scalef32_pk_fp4_f32(acc, v0_, v1_, 1.0f, 1)
                : b == 2 ? __builtin_amdgcn_cvt_scalef32_pk_fp4_f32(acc, v0_, v1_, 1.0f, 2) : __builtin_amdgcn_cvt_scalef32_pk_fp4_f32(acc, v0_, v1_, 1.0f, 3); }
        w[d] = acc; }
    *(u32x4*)(dst + ((size_t)(F.lane >> 3) * NEXP + row) * FP4_SLICE + (F.lane & 7) * 16) = (u32x4){w[0], w[1], w[2], w[3]};
    if (F.lane == 0) inv[2 * row] = isc;
}
template <int FMT>
DI void convert_rows_deep(Frame& F, const float* __restrict__ src, unsigned char* __restrict__ dst, float* __restrict__ inv, int rows, int wv, int nw, LAS unsigned char* wl, const float* __restrict__ gain) {
    if (wv >= rows) return;
    const int last = wv + ((rows - 1 - wv) / nw) * nw;
    f32x4 va[8], vb[8], vc[8];
#define CVD_LOAD(V, rw) do { const int rr_ = (rw) < last ? (rw) : last; const float* rp_ = src + (size_t)rr_ * D + F.lane * 4; \
        _Pragma("unroll") for (int q = 0; q < 8; ++q) V[q] = *(const f32x4*)(rp_ + q * 256); } while (0)
#define CVD_STEP(V, rw) do { const float mx_ = convert_row_a<FMT>(F, V, wl, gain); CVD_LOAD(V, (rw) + 3 * nw); \
        convert_row_b<FMT>(F, mx_, dst, inv, (rw) < last ? (rw) : last, wl); } while (0)
    CVD_LOAD(va, wv); CVD_LOAD(vb, wv + nw); CVD_LOAD(vc, wv + 2 * nw);
    for (int row = wv; row < rows; row += 3 * nw) { CVD_STEP(va, row); CVD_STEP(vb, row + nw); CVD_STEP(vc, row + 2 * nw); }
#undef CVD_LOAD
#undef CVD_STEP
}
typedef __bf16 bf16x32_t __attribute__((ext_vector_type(32)));
typedef __bf16 bf16x2_t __attribute__((ext_vector_type(2)));
constexpr int FP6_SLICE = 192;
typedef int i32x8 __attribute__((ext_vector_type(8)));
DI unsigned fp8_code(float v) {
    const unsigned u = __float_as_uint(v), a = u & 0x7fffffffu;
    unsigned c = a >= 0x3c800000u ? ((a + 0x7ffffu + ((a >> 20) & 1u)) >> 20) - 960u : (unsigned)__builtin_rintf(__uint_as_float(a) * 512.f);
    c = c > 126u ? 126u : c;
    return c | ((u >> 24) & 0x80u);
}
constexpr float PU_HSC = 8.f;
constexpr int PU_WL = 16384;
constexpr int PU_RING = 4096, PU_GRP = 2048, PU_R = 6;
DI void peer_u_round(LAS unsigned char* wl, const bf16_t* __restrict__ x2b, const float* __restrict__ part2, const int* __restrict__ idx,
                     const unsigned char* __restrict__ eu, bf16_t* __restrict__ pd, int t0, int x, int lane) {
    asm volatile("" : "+v"(lane));
#pragma unroll
    for (int i8 = 0; i8 < 8; ++i8) { const u32x4 v = *(const u32x4*)(idx + (size_t)t0 * 128 + (i8 * 64 + lane) * 4);
        *(LAS u32x2*)(wl + (i8 * 64 + lane) * 8) = (u32x2){v[0] | (v[1] << 16), v[2] | (v[3] << 16)}; }
    { const int tk = lane >> 2, qt = lane & 3, tok = t0 + tk;
      float ss;
      { const f32x4 p0 = *(const f32x4*)(part2 + (size_t)tok * 32 + qt * 8), p1 = *(const f32x4*)(part2 + (size_t)tok * 32 + qt * 8 + 4);
        ss = ((p0[0] + p0[1]) + (p0[2] + p0[3])) + ((p1[0] + p1[1]) + (p1[2] + p1[3])); }
      ss += __shfl_xor(ss, 1); ss += __shfl_xor(ss, 2);
      const float rg = rsqrtf(ss * (1.f / D) + EPS) * PU_HSC;
      const bf16_t* xp = x2b + (size_t)tok * D + x * 256 + qt * 64;
      LAS unsigned char* hp = wl + PU_RING + tk * 256 + qt * 64;
#pragma unroll
      for (int q = 0; q < 4; ++q) { unsigned hw[4];
#pragma unroll
          for (int q2 = 0; q2 < 2; ++q2) { const u32x4 w = *(const u32x4*)(xp + q * 16 + q2 * 8); f32x4 a, b; pg8::up8(w, a, b); a = a * rg; b = b * rg;
              { int lo = __builtin_amdgcn_cvt_pk_fp8_f32(a[0], a[1], 0, false); lo = __builtin_amdgcn_cvt_pk_fp8_f32(a[2], a[3], lo, true);
                int hi = __builtin_amdgcn_cvt_pk_fp8_f32(b[0], b[1], 0, false); hi = __builtin_amdgcn_cvt_pk_fp8_f32(b[2], b[3], hi, true);
                hw[2 * q2] = (unsigned)lo; hw[2 * q2 + 1] = (unsigned)hi; } }
          *(LAS u32x4*)(hp + q * 16) = (u32x4){hw[0], hw[1], hw[2], hw[3]}; } }
    const int i = lane & 15, kb = lane >> 4, r = i >> 2;
    i32x8 hB[2];
#pragma unroll
    for (int s2 = 0; s2 < 2; ++s2) { const LAS unsigned char* hp = wl + PU_RING + i * 256 + s2 * 128;
        const int c0 = 32 * (((kb >> 1) + r) & 3) + 16 * (kb & 1), c1 = 32 * ((((kb + 4) >> 1) + r) & 3) + 16 * (kb & 1);
        const u32x4 v0 = *(const LAS u32x4*)(hp + c0), v1 = *(const LAS u32x4*)(hp + c1);
        hB[s2] = (i32x8){(int)v0[0], (int)v0[1], (int)v0[2], (int)v0[3], (int)v1[0], (int)v1[1], (int)v1[2], (int)v1[3]}; }
    asm volatile("s_waitcnt lgkmcnt(0)" ::: "memory");
    const int roff = i * 64 + 16 * ((kb + r) & 3);
    const int Q = lane >> 2;
    const unsigned char* ub = eu + (size_t)x * NEXP * FP4_SLICE + (lane & 3) * 16;
    const LAS unsigned short* lix = (const LAS unsigned short*)wl + Q * 128;
    const bool outl = kb == (i >> 2);
    unsigned m1 = 0u - (unsigned)(lane & 1), m2 = 0u - (unsigned)((lane >> 1) & 1);
    asm volatile("" : "+v"(m1), "+v"(m2));
    bf16_t* pdo = pd + ((size_t)x * M + t0 + i) * 128;
    LAS unsigned char* ring = wl + PU_RING;
#define PU_DMA(j, slot) PU_DMAE(lix[(j)], slot)
#define PU_DMAE(e, slot) do { const unsigned char* sp_ = ub + (size_t)(e) * FP4_SLICE; \
        __builtin_amdgcn_global_load_lds((const unsigned*)sp_, (LAS unsigned*)(ring + (slot) * PU_GRP), 16, 0, 0); \
        __builtin_amdgcn_global_load_lds((const unsigned*)(sp_ + 64), (LAS unsigned*)(ring + (slot) * PU_GRP + 1024), 16, 0, 0); } while (0)
#define PU_COMP(slot, OV) do { const LAS unsigned char* gp_ = ring + (slot) * PU_GRP + roff; \
        const u32x4 a0v_ = *(const LAS u32x4*)gp_, a1v_ = *(const LAS u32x4*)(gp_ + 1024); \
        const i32x8 a0_ = {(int)a0v_[0], (int)a0v_[1], (int)a0v_[2], (int)a0v_[3], 0, 0, 0, 0}; \
        const i32x8 a1_ = {(int)a1v_[0], (int)a1v_[1], (int)a1v_[2], (int)a1v_[3], 0, 0, 0, 0}; \
        f32x4 d_ = {0.f, 0.f, 0.f, 0.f}; \
        d_ = __builtin_amdgcn_mfma_scale_f32_16x16x128_f8f6f4(a0_, hB[0], d_, 4, 0, 0, 0, 0, 0); \
        d_ = __builtin_amdgcn_mfma_scale_f32_16x16x128_f8f6f4(a1_, hB[1], d_, 4, 0, 0, 0, 0, 0); \
        const unsigned lo_ = (m1 & __float_as_uint(d_[1])) | (~m1 & __float_as_uint(d_[0])), hi_ = (m1 & __float_as_uint(d_[3])) | (~m1 & __float_as_uint(d_[2])); \
        OV = __uint_as_float((m2 & hi_) | (~m2 & lo_)); } while (0)
    PU_DMA(0, 0); PU_DMA(1, 1); PU_DMA(2, 2); PU_DMA(3, 3); PU_DMA(4, 4);
#pragma unroll 1
    for (int j0 = 0; j0 < 120; j0 += 24) {
        float o[8];
        unsigned en[24];
#pragma unroll
        for (int jj = 0; jj < 24; ++jj) en[jj] = lix[j0 + jj + 5];
#pragma unroll
        for (int jj = 0; jj < 24; ++jj) {
            PU_DMAE(en[jj], (jj + 5) % 6);
            asm volatile("s_waitcnt vmcnt(10)" ::: "memory");
            PU_COMP(jj % 6, o[jj & 7]);
            asm volatile("s_waitcnt lgkmcnt(0)" ::: "memory");
            if ((jj & 7) == 7) { if (outl) *(u32x4*)(pdo + j0 + jj - 7) = (u32x4){pg8::cvt_pk_bf16(o[0], o[1]), pg8::cvt_pk_bf16(o[2], o[3]), pg8::cvt_pk_bf16(o[4], o[5]), pg8::cvt_pk_bf16(o[6], o[7])}; } }
    }
    { float o[8];
#pragma unroll
      for (int jj = 0; jj < 8; ++jj) {
          PU_DMA(120 + jj + 5 < 127 ? 120 + jj + 5 : 127, (jj + 5) % 6);
          asm volatile("s_waitcnt vmcnt(10)" ::: "memory");
          PU_COMP(jj % 6, o[jj & 7]);
          asm volatile("s_waitcnt lgkmcnt(0)" ::: "memory"); }
      if (outl) *(u32x4*)(pdo + 120) = (u32x4){pg8::cvt_pk_bf16(o[0], o[1]), pg8::cvt_pk_bf16(o[2], o[3]), pg8::cvt_pk_bf16(o[4], o[5]), pg8::cvt_pk_bf16(o[6], o[7])}; }
    asm volatile("s_waitcnt vmcnt(0) lgkmcnt(0)" ::: "memory");
#undef PU_DMA
#undef PU_DMAE
#undef PU_COMP
}
DI void peer_act(Frame& F, const bf16_t* __restrict__ pd, const int* __restrict__ idx, const float* __restrict__ gate, const float* __restrict__ scu, const float* __restrict__ scv, float* __restrict__ act) {
    for (size_t i = ((size_t)F.vcu * NTHR + F.tid) * 4; i < (size_t)M * 128; i += (size_t)F.G * NTHR * 4) {
        f32x4 p[8];
#pragma unroll
        for (int x = 0; x < 8; ++x) { const u32x2 w = *(const u32x2*)(pd + (size_t)x * M * 128 + i);
            p[x] = (f32x4){__uint_as_float(w[0] << 16), __uint_as_float(w[0] & 0xffff0000u), __uint_as_float(w[1] << 16), __uint_as_float(w[1] & 0xffff0000u)}; }
        const u32x4 e4 = *(const u32x4*)(idx + i); const f32x4 g4 = *(const f32x4*)(gate + i);
        const f32x4 s = ((p[0] + p[1]) + (p[2] + p[3])) + ((p[4] + p[5]) + (p[6] + p[7]));
        f32x4 o;
#pragma unroll
        for (int q = 0; q < 4; ++q) { const v2f sc = *(const v2f*)(scu + 2 * e4[q]);
            o[q] = gelu_exact(s[q] * (sc[0] * (1.f / PU_HSC))) * g4[q] * sc[1]; }
        *(f32x4*)(act + i) = o;
    }
}
DI void peer_v_round(LAS unsigned char* wl, const bf16_t* __restrict__ x2b, const int* __restrict__ idx, const float* __restrict__ act, const unsigned char* __restrict__ ev,
                     bf16_t* __restrict__ yb, float* __restrict__ ssq, int t0, int x, int lane) {
    asm volatile("" : "+v"(lane));
    const int g = lane >> 3, l8 = lane & 7, tok = t0 + g;
    LAS int* lidx = (LAS int*)wl; LAS float* lact = (LAS float*)(wl + 4096);
#pragma unroll
    for (int i = 0; i < 4; ++i) { *(LAS u32x4*)(wl + (i * 64 + lane) * 16) = *(const u32x4*)(idx + (size_t)t0 * 128 + (i * 64 + lane) * 4);
        *(LAS f32x4*)(wl + 4096 + (i * 64 + lane) * 16) = *(const f32x4*)(act + (size_t)t0 * 128 + (i * 64 + lane) * 4); }
    f32x32 o;
#pragma unroll
    for (int k = 0; k < 32; ++k) o[k] = 0.f;
    asm volatile("s_waitcnt vmcnt(0) lgkmcnt(0)" ::: "memory");
    const unsigned char* vb = ev + (size_t)x * NEXP * FP4_SLICE + l8 * 16;
#define PV_LOAD(VB, j0) do { _Pragma("unroll") for (int jj = 0; jj < 8; ++jj) { const int e_ = lidx[g * 128 + (j0) + jj]; \
        VB[jj] = *(const u32x4*)(vb + (size_t)e_ * FP4_SLICE); } } while (0)
#define PV_DEC(W, D, B) __builtin_amdgcn_cvt_scalef32_pk_f32_fp4(W[D], 1.0f, B)
#define PV_ACC(VB, j0) do { _Pragma("unroll") for (int jj = 0; jj < 8; ++jj) { f32x32 vf_; \
        _Pragma("unroll") for (int d = 0; d < 4; ++d) { const f32x2v p0_ = PV_DEC(VB[jj], d, 0), p1_ = PV_DEC(VB[jj], d, 1), p2_ = PV_DEC(VB[jj], d, 2), p3_ = PV_DEC(VB[jj], d, 3); \
            vf_[d * 8] = p0_[0]; vf_[d * 8 + 1] = p0_[1]; vf_[d * 8 + 2] = p1_[0]; vf_[d * 8 + 3] = p1_[1]; vf_[d * 8 + 4] = p2_[0]; vf_[d * 8 + 5] = p2_[1]; vf_[d * 8 + 6] = p3_[0]; vf_[d * 8 + 7] = p3_[1]; } \
        o += vf_ * lact[g * 128 + (j0) + jj]; __builtin_amdgcn_sched_barrier(0); } } while (0)
    u32x4 vA[8], vB[8];
    PV_LOAD(vA, 0);
#pragma unroll 1
    for (int j0 = 0; j0 < 112; j0 += 16) {
        PV_LOAD(vB, j0 + 8);
        PV_ACC(vA, j0);
        PV_LOAD(vA, j0 + 16);
        PV_ACC(vB, j0 + 8);
    }
    PV_LOAD(vB, 120);
    PV_ACC(vA, 112);
    PV_ACC(vB, 120);
#undef PV_LOAD
#undef PV_ACC
#undef PV_DEC
    const int c0 = x * 256 + l8 * 32; float ss = 0.f;
#pragma unroll
    for (int q = 0; q < 4; ++q) { const u32x4 w = *(const u32x4*)(x2b + (size_t)tok * D + c0 + q * 8); f32x4 ta, tb; pg8::up8(w, ta, tb);
        const f32x4 ya = {o[q * 8] + ta[0], o[q * 8 + 1] + ta[1], o[q * 8 + 2] + ta[2], o[q * 8 + 3] + ta[3]}, yb_ = {o[q * 8 + 4] + tb[0], o[q * 8 + 5] + tb[1], o[q * 8 + 6] + tb[2], o[q * 8 + 7] + tb[3]};
        *(u32x4*)(yb + (size_t)tok * D + c0 + q * 8) = pg8::pack8(ya, yb_);
        ss += (ya[0] * ya[0] + ya[1] * ya[1]) + (ya[2] * ya[2] + ya[3] * ya[3]) + (yb_[0] * yb_[0] + yb_[1] * yb_[1]) + (yb_[2] * yb_[2] + yb_[3] * yb_[3]); }
    ss += __shfl_xor(ss, 1); ss += __shfl_xor(ss, 2); ss += __shfl_xor(ss, 4);
    if (l8 == 0) ssq[(size_t)tok * 8 + x] = ss;
    asm volatile("s_waitcnt lgkmcnt(0)" ::: "memory");
}
DI void peer_norm_rows(Frame& F, const bf16_t* __restrict__ yb, float* __restrict__ out, const float* __restrict__ ssq, const float* __restrict__ gfin) {
    for (int row0 = F.gw * 2; row0 < M; row0 += F.NGW * 2) {
        u32x4 w[2][4]; float r[2];
#pragma unroll
        for (int i = 0; i < 2; ++i) { const int row = row0 + i;
#pragma unroll
            for (int j = 0; j < 4; ++j) w[i][j] = *(const u32x4*)(yb + (size_t)row * D + (F.lane + 64 * j) * 8);
            const f32x4 s0 = *(const f32x4*)(ssq + (size_t)row * 8), s1 = *(const f32x4*)(ssq + (size_t)row * 8 + 4);
            r[i] = rsqrtf(((s0[0] + s0[1]) + (s0[2] + s0[3]) + (s1[0] + s1[1]) + (s1[2] + s1[3])) * (1.f / D) + EPS); }
#pragma unroll
        for (int i = 0; i < 2; ++i)
#pragma unroll
            for (int j = 0; j < 4; ++j) { f32x4 a, b; pg8::up8(w[i][j], a, b);
                const f32x4 ga = *(const f32x4*)(gfin + (F.lane + 64 * j) * 8), gb = *(const f32x4*)(gfin + (F.lane + 64 * j) * 8 + 4);
                float* op = out + (size_t)(row0 + i) * D + (F.lane + 64 * j) * 8;
                *(f32x4*)op = a * ga * r[i]; *(f32x4*)(op + 4) = b * gb * r[i]; }
    }
}

template <class Sched> DI void build_rtab(Frame& F, const Sched& S, const float* part) {
    LAS float* rt = (LAS float*)(F.lds + SPARE_OFF);
    pg8::Unit u;
    for (int i = 0; i < 12 && S.next(i, u); ++i) {
        if (F.tid < 256) { const float4* pp = (const float4*)(part + (size_t)(u.pm * 256 + F.tid) * 32); float s = 0.f;
#pragma unroll
            for (int j = 0; j < 8; ++j) { const float4 v = pp[j]; s += (v.x + v.y) + (v.z + v.w); }
            rt[i * 256 + F.tid] = rsqrtf(s * (1.f / D) + EPS); }
    }
    __syncthreads();
}

constexpr int CW_BAR = 4096;
#define PH(k)
__global__ void __launch_bounds__(NTHR, 2) mega_fwd(Args args) {
    extern __shared__ __attribute__((aligned(16))) unsigned char lds_raw[];
    Frame F;
    F.lds = (LAS unsigned char*)lds_raw; F.ldsg = lds_raw;
    F.tid = threadIdx.x; F.lane = F.tid & 63; F.wave = __builtin_amdgcn_readfirstlane(F.tid >> 6);
    F.G = gridDim.x; { const int bx = blockIdx.x; F.vcu = (F.G % 8 == 0) ? (bx % 8) * (F.G / 8) + bx / 8 : bx; }
    F.gw = F.vcu * NWAVES + F.wave; F.NGW = F.G * NWAVES;
    volatile LAS unsigned* MISC = (volatile LAS unsigned*)(F.lds + MISC_OFF);
    if (F.tid < 64) MISC[F.tid] = 0u;
    __syncthreads();
    unsigned* ctl = (unsigned*)(args.ws + WS_CTL);
    XcdBarrier bar = xcd_barrier_post(ctl + CW_BAR, MISC + 8);
    const int c = (int)blockIdx.x, G = F.G;
    using pg8::SchedStd; using pg8::SchedOne; using pg8::Unit;

    PH(0) p0_prologue(F, args);
    xcd_barrier(bar);

    const int NH = G / 16, GG = G - NH;
    if (c < GG) {
        { SchedStd S{(const char*)WB(WS_H1), (const char*)WB(WS_WINT), nullptr, nullptr, 2048, 2048, 64, 40, GG, c, 1 << 20, 0, 0};
          pg8::EpiProj E{WB(WS_PROJA), args.ws + WS_PROJG};
          pg8::gemm_phase<pg8::EpiProj, SchedStd, true>(F.lds, 2048, 2048, 2048, S, E); }
        const int k11 = __builtin_amdgcn_readfirstlane(2560 % GG);
        { int c1 = c - k11; c1 = c1 < 0 ? c1 + GG : c1; c1 = __builtin_amdgcn_readfirstlane(c1);
          SchedStd S{(const char*)WB(WS_MEMN), (const char*)WB(WS_WKVT), nullptr, nullptr, 2048, 2048, 4, 16, GG, c1, 1 << 20, 0, 0};
          pg8::EpiBf E{WB(WS_KVM), 4096};
          pg8::gemm_phase<pg8::EpiBf, SchedStd, true>(F.lds, 2048, 2048, 2048, S, E); }
        { int c2 = c - k11 - 64; c2 = c2 < 0 ? c2 + GG : c2; c2 = c2 < 0 ? c2 + GG : c2; c2 = __builtin_amdgcn_readfirstlane(c2);
#pragma unroll 1
          for (int q = 0; q < 4; ++q) {
              SchedOne S; const int j = __builtin_amdgcn_readfirstlane(c2 * 4 + q); S.have = (c2 < 16); const int pmj = (j >> 3) & 7, pn = j & 7;
              S.u0.pm = pmj; S.u0.pn = pn; S.u0.idx = 0; S.u0.s = 0;
              S.u0.a = (const char*)(WB(WS_AKEYS) + (size_t)pmj * 256 * 256); S.u0.b = (const char*)(WB(WS_WPQN) + (size_t)pn * 256 * 2048 + pmj * 256);
              pg8::EpiBf E{WB(WS_WPPT), 2048};
              pg8::gemm_phase<pg8::EpiBf, SchedOne, true>(F.lds, 256, 2048, 256, S, E);
          } }
    }
    if (NH == 0 || c >= GG) {
        const int hw = NH ? (c - GG) * NWAVES + F.wave : F.gw, HW = NH ? NH * NWAVES : F.NGW;
        p0_deferred(F, args, hw, HW);
        convert_rows_deep<4>(F, args.in[20], args.ws + WS_EV, WF(WS_SCU) + 1, NEXP, hw, HW, F.lds + F.wave * 17408, nullptr);
    }
    xcd_barrier(bar);

    PH(2) for (int i = 0; i < 2; ++i) { const int unit = F.vcu * 2 + i; if (unit < 512) battn_unit(F.lds, WB(WS_PROJA), args.in[6], WB(WS_OATT), unit); }
    PH(12) for (int gid = F.vcu * NTHR + F.tid; gid < (M / 16) * 128; gid += G * NTHR) conv_item(WB(WS_PROJA), args.in[4], args.in[5], WB(WS_YC), gid);
    PH(13) {
        SchedOne S; S.have = (c < 256); S.u0.idx = 0; S.u0.s = 0;
        const int j = c & 127, b = j >> 5, head = (j >> 3) & 3, t8 = j & 7;
        if (c < 128) {
            S.u0.pm = b * 4 + head; S.u0.pn = t8;
            S.u0.a = (const char*)(WB(WS_KVM) + (size_t)(b * 256) * 4096 + head * 512); S.u0.b = (const char*)(WB(WS_WCQN) + (size_t)(t8 * 256) * 2048 + head * 512);
            pg8::EpiBf E{WB(WS_WST), 2048};
            pg8::gemm_phase<pg8::EpiBf, SchedOne, true>(F.lds, 4096, 2048, 512, S, E);
        } else {
            S.u0.pm = b * 8 + t8; S.u0.pn = head;
            S.u0.a = (const char*)(WB(WS_WCOT) + (size_t)(t8 * 256) * 2048 + head * 512); S.u0.b = (const char*)(WB(WS_KVM) + (size_t)(b * 256) * 4096 + 2048 + head * 512);
            pg8::EpiBf E{WB(WS_WOT), 1024};
            pg8::gemm_phase<pg8::EpiBf, SchedOne, true>(F.lds, 2048, 4096, 512, S, E);
        }
    }
    xcd_barrier(bar);

    PH(3) {
        SchedStd S{(const char*)WB(WS_OATT), (const char*)WB(WS_WATT), (const char*)WB(WS_YC), (const char*)WB(WS_WCONV), 1024, 1024, 64, 8, G, c, 1 << 20, 1, 0};
        pg8::EpiMerge E{args.ws + WS_PROJG, WB(WS_SCR), WB(WS_MERGED)};
        pg8::gemm_phase<pg8::EpiMerge, SchedStd, true>(F.lds, 1024, 1024, 1024, S, E);
    }
    xcd_barrier(bar);

    PH(4) {
        SchedStd S{(const char*)WB(WS_MERGED), (const char*)WB(WS_WMIX), nullptr, nullptr, 2048, 2048, 64, 8, G, c, 1 << 20, 0, 0};
        pg8::EpiRes<false> E{args.in[0], WB(WS_X1BF), WF(WS_PART1)};
        pg8::gemm_phase<pg8::EpiRes<false>, SchedStd, true>(F.lds, 2048, 2048, 2048, S, E);
    }
    xcd_barrier(bar);

    PH(5) {
        SchedStd S{(const char*)WB(WS_X1BF), (const char*)WB(WS_WST), nullptr, nullptr, 2048, 2048, 64, 4, G, c, 16, 0, (size_t)1024 * 2048 * 2};
        build_rtab(F, S, WF(WS_PART1));
        pg8::EpiSoftmax E{WB(WS_PB), (const LAS float*)(F.lds + SPARE_OFF)};
        pg8::gemm_phase<pg8::EpiSoftmax, SchedStd, false>(F.lds, 2048, 2048, 2048, S, E);
    }
    xcd_barrier(bar);

    PH(6) {
        SchedStd S{(const char*)WB(WS_PB), (const char*)WB(WS_WOT), nullptr, nullptr, 1024, 1024, 64, 8, G, c, 16, 0, (size_t)2048 * 1024 * 2};
        pg8::EpiRes<true> E{WB(WS_X1BF), WB(WS_X2BF), WF(WS_PART2)};
        pg8::gemm_phase<pg8::EpiRes<true>, SchedStd, true>(F.lds, 1024, 1024, 1024, S, E);
    }
    xcd_barrier(bar);

    PH(7) {
        SchedStd S{(const char*)WB(WS_X2BF), (const char*)WB(WS_WPPT), nullptr, nullptr, 2048, 2048, 64, 8, G, c, 1 << 20, 0, 0};
        build_rtab(F, S, WF(WS_PART2));
        pg8::EpiScore E{WB(WS_SCORES), (const LAS float*)(F.lds + SPARE_OFF)};
        pg8::gemm_phase<pg8::EpiScore, SchedStd, true>(F.lds, 2048, 2048, 2048, S, E);
    }
    xcd_barrier(bar);

    PH(8) for (int it = F.gw; it < M / 4; it += F.NGW) topk_item4(WB(WS_SCORES), (int*)(args.ws + WS_IDX), WF(WS_GATE), it, F.lds + F.wave * 17408, F.lane);
    PH(14) convert_fp4_rows<true>(F, args.in[19], args.ws + WS_EU, WF(WS_SCU), NEXP, F.gw, F.NGW, F.lds + F.wave * 17408, args.in[16]);
    xcd_barrier(bar);

    const int xv = c & 7, wx = (c >> 3) * NWAVES + F.wave, nwx = (G >> 3) * NWAVES;
    PH(9) for (int t0 = wx * 16; t0 < M; t0 += nwx * 16)
        peer_u_round(F.lds + F.wave * PU_WL, WB(WS_X2BF), WF(WS_PART2), (const int*)(args.ws + WS_IDX), args.ws + WS_EU, WB(WS_PD), t0, xv, F.lane);
    xcd_barrier(bar);
    PH(15) peer_act(F, WB(WS_PD), (const int*)(args.ws + WS_IDX), WF(WS_GATE), WF(WS_SCU), WF(WS_SCV), WF(WS_ACT));
    xcd_barrier(bar);
    PH(16) for (int t0 = wx * 8; t0 < M; t0 += nwx * 8)
        peer_v_round(F.lds + F.wave * 8192, WB(WS_X2BF), (const int*)(args.ws + WS_IDX), WF(WS_ACT), args.ws + WS_EV, WB(WS_YB), WF(WS_SSQ), t0, xv, F.lane);
    xcd_barrier(bar);
    PH(17) peer_norm_rows(F, WB(WS_YB), args.out, WF(WS_SSQ), args.in[21]);
}

extern "C" void kernel_launch(void* const* d_in, const int* in_sizes, int n_in, void* d_out, int out_size, void* d_ws, size_t ws_size, hipStream_t stream) {
    static int grid = 0;
    if (grid == 0) {
        if (n_in != 22 || ws_size < WS_END) { fprintf(stderr, "kernel_launch: unexpected n_in %d or ws_size %zu (< %zu)\n", n_in, ws_size, (size_t)WS_END); grid = -1; return; }
        int dev = 0, cus = 0, per_cu = 0;
        if (hipGetDevice(&dev) != hipSuccess || hipDeviceGetAttribute(&cus, hipDeviceAttributeMultiprocessorCount, dev) != hipSuccess) { grid = -1; return; }
        if (hipFuncSetAttribute((const void*)mega_fwd, hipFuncAttributeMaxDynamicSharedMemorySize, LDS_BYTES) != hipSuccess) { fprintf(stderr, "kernel_launch: hipFuncSetAttribute failed\n"); grid = -1; return; }
        if (hipOccupancyMaxActiveBlocksPerMultiprocessor(&per_cu, (const void*)mega_fwd, NTHR, LDS_BYTES) != hipSuccess || per_cu < 1) { fprintf(stderr, "kernel_launch: occupancy query says %d\n", per_cu); per_cu = 1; }
        (void)hipGetLastError();
        grid = cus;
        if (grid > 256) grid = 256;
    }
    if (grid < 0) return;
    (void)hipMemsetAsync((char*)d_ws + WS_CTL, 0, 65536, stream);
    Args a{};
    for (int i = 0; i < 22; ++i) a.in[i] = (const float*)d_in[i];
    a.out = (float*)d_out; a.ws = (unsigned char*)d_ws;
    void* kargs[] = {&a};
    hipError_t e = hipLaunchCooperativeKernel((const void*)mega_fwd, dim3(grid), dim3(NTHR), kargs, LDS_BYTES, stream);
    if (e != hipSuccess) fprintf(stderr, "kernel_launch: cooperative launch failed: %s (grid %d)\n", hipGetErrorString(e), grid);
}
```
